# Optimizing an MI355X kernel written in HIP

```python
import math
import jax, jax.numpy as jnp
from jax import lax
import numpy as np

D_MODEL = 2048
BATCH = 8
SEQ = 4096
DEPTH = 4
DEC_BATCH = 2
DEC_SEQ = 8192
PAST_LEN = 128

GRID_W = 64
Q_BLOCK = 128
HEAD_DIM = 128
ROPE_THETA = 10000.0
EPS = 1e-6
A_HEADS = D_MODEL // HEAD_DIM
A_KV_HEADS = A_HEADS // 4
A_GROUP = A_HEADS // A_KV_HEADS
A_WIDTH = A_HEADS * HEAD_DIM
A_KV_WIDTH = A_KV_HEADS * HEAD_DIM
A_IN = 2 * A_WIDTH + 2 * A_KV_WIDTH
B_HEADS = D_MODEL // (2 * HEAD_DIM)
B_WIDTH = B_HEADS * 2 * HEAD_DIM
B_IN = 4 * B_WIDTH
N_A = (DEPTH + 1) // 2
N_B = DEPTH // 2

kernel_name = "hybrid_gqa_axial_diffattn_encoder"


def rmsnorm(x, g):
    xf = x.astype(jnp.float32)
    y = xf * lax.rsqrt(jnp.mean(xf * xf, axis=-1, keepdims=True) + EPS)
    return (y * g.astype(jnp.float32)).astype(x.dtype)


def rope(x, pos, dim):
    inv = 1.0 / (ROPE_THETA ** (jnp.arange(0, dim, 2, dtype=jnp.float32) / dim))
    ang = pos[:, None] * inv[None, :]
    cos = jnp.cos(ang)[None, :, None, :]
    sin = jnp.sin(ang)[None, :, None, :]
    x1, x2 = jnp.split(x.astype(jnp.float32), 2, axis=-1)
    return jnp.concatenate([x1 * cos - x2 * sin, x2 * cos + x1 * sin], axis=-1).astype(x.dtype)


def axial_rope(x, row, col):
    half = HEAD_DIM // 2
    return jnp.concatenate([rope(x[..., :half], row, half), rope(x[..., half:], col, half)], axis=-1)


def gqa_axial_layer(x, norm_g, w_in, q_g, k_g, w_out):
    B, S, _ = x.shape
    h = rmsnorm(x, norm_g)
    proj = h @ w_in
    q, k, v, z = jnp.split(proj, [A_WIDTH, A_WIDTH + A_KV_WIDTH, A_WIDTH + 2 * A_KV_WIDTH], axis=-1)
    q = rmsnorm(q.reshape(B, S, A_HEADS, HEAD_DIM), q_g)
    k = rmsnorm(k.reshape(B, S, A_KV_HEADS, HEAD_DIM), k_g)
    v = v.reshape(B, S, A_KV_HEADS, HEAD_DIM)
    n_rows = S // GRID_W
    row = jnp.repeat(jnp.arange(n_rows, dtype=jnp.float32), GRID_W)
    col = jnp.tile(jnp.arange(GRID_W, dtype=jnp.float32), n_rows)
    q = axial_rope(q, row, col) * (HEAD_DIM ** -0.5)
    k = axial_rope(k, row, col)
    nb = S // Q_BLOCK
    qb = q.reshape(B, nb, Q_BLOCK, A_KV_HEADS, A_GROUP, HEAD_DIM).transpose(1, 0, 2, 3, 4, 5)

    def block(q_blk):
        s = jnp.einsum('bqhgd,bkhd->bhgqk', q_blk, k).astype(jnp.float32)
        p = jax.nn.softmax(s, axis=-1).astype(v.dtype)
        return jnp.einsum('bhgqk,bkhd->bqhgd', p, v)

    o = lax.map(block, qb).transpose(1, 0, 2, 3, 4, 5).reshape(B, S, A_WIDTH)
    return x + (o * jax.nn.silu(z)) @ w_out


def diff_attn_layer(x, layer_idx, norm_g, w_in, q_g, k_g, lq1, lk1, lq2, lk2, subln_g, w_out):
    B, S, _ = x.shape
    lam_init = 0.8 - 0.6 * math.exp(-0.3 * layer_idx)
    h = rmsnorm(x, norm_g)
    proj = h @ w_in
    q, k, v, z = jnp.split(proj, [B_WIDTH, 2 * B_WIDTH, 3 * B_WIDTH], axis=-1)
    q = rmsnorm(q.reshape(B, S, 2 * B_HEADS, HEAD_DIM), q_g)
    k = rmsnorm(k.reshape(B, S, 2 * B_HEADS, HEAD_DIM), k_g)
    v = v.reshape(B, S, B_HEADS, 2 * HEAD_DIM)
    pos = jnp.arange(S, dtype=jnp.float32)
    q = rope(q, pos, HEAD_DIM) * (HEAD_DIM ** -0.5)
    k = rope(k, pos, HEAD_DIM)
    f32 = jnp.float32
    lam = (jnp.exp(jnp.sum(lq1.astype(f32) * lk1.astype(f32)))
           - jnp.exp(jnp.sum(lq2.astype(f32) * lk2.astype(f32))) + lam_init)
    nb = S // Q_BLOCK
    qb = q.reshape(B, nb, Q_BLOCK, 2 * B_HEADS, HEAD_DIM).transpose(1, 0, 2, 3, 4)

    def block(q_blk):
        s = jnp.einsum('bqnd,bknd->bnqk', q_blk, k).astype(f32)
        p = jax.nn.softmax(s, axis=-1).reshape(B, B_HEADS, 2, Q_BLOCK, S)
        a = (p[:, :, 0] - lam * p[:, :, 1]).astype(v.dtype)
        return jnp.einsum('bhqk,bkhe->bqhe', a, v)

    o = lax.map(block, qb).transpose(1, 0, 2, 3, 4).reshape(B, S, B_HEADS, 2 * HEAD_DIM)
    o = (rmsnorm(o, subln_g) * (1.0 - lam_init)).reshape(B, S, B_WIDTH)
    return x + (o * jax.nn.silu(z)) @ w_out


def run_trunk(x, a_norm, a_w_in, a_q_norm, a_k_norm, a_w_out,
              b_norm, b_w_in, b_q_norm, b_k_norm, b_lambda_q1, b_lambda_k1,
              b_lambda_q2, b_lambda_k2, b_subln, b_w_out):
    for i in range(DEPTH):
        j = i // 2
        if i % 2 == 0:
            x = gqa_axial_layer(x, a_norm[j], a_w_in[j], a_q_norm[j], a_k_norm[j], a_w_out[j])
        else:
            x = diff_attn_layer(x, i, b_norm[j], b_w_in[j], b_q_norm[j], b_k_norm[j],
                                b_lambda_q1[j], b_lambda_k1[j], b_lambda_q2[j], b_lambda_k2[j],
                                b_subln[j], b_w_out[j])
    return x


def setup_inputs(seed: int = 0) -> dict:
    key = jax.random.key(seed)
    ks = jax.random.split(key, 17)
    f32 = jnp.float32
    nrm = lambda k, shape, s: jax.random.normal(k, shape, f32) * s
    gain = lambda k, shape: 1.0 + 0.02 * jax.random.normal(k, shape, f32)
    return {
        "x_prompt": jax.random.normal(ks[0], (BATCH, SEQ, D_MODEL), f32),
        "x_sample": jax.random.normal(ks[1], (DEC_BATCH, DEC_SEQ, D_MODEL), f32),
        "a_norm": gain(ks[2], (N_A, D_MODEL)),
        "a_w_in": nrm(ks[3], (N_A, D_MODEL, A_IN), D_MODEL ** -0.5),
        "a_q_norm": gain(ks[4], (N_A, HEAD_DIM)),
        "a_k_norm": gain(ks[5], (N_A, HEAD_DIM)),
        "a_w_out": nrm(ks[6], (N_A, A_WIDTH, D_MODEL), A_WIDTH ** -0.5),
        "b_norm": gain(ks[7], (N_B, D_MODEL)),
        "b_w_in": nrm(ks[8], (N_B, D_MODEL, B_IN), D_MODEL ** -0.5),
        "b_q_norm": gain(ks[9], (N_B, HEAD_DIM)),
        "b_k_norm": gain(ks[10], (N_B, HEAD_DIM)),
        "b_lambda_q1": nrm(ks[11], (N_B, HEAD_DIM), 0.1),
        "b_lambda_k1": nrm(ks[12], (N_B, HEAD_DIM), 0.1),
        "b_lambda_q2": nrm(ks[13], (N_B, HEAD_DIM), 0.1),
        "b_lambda_k2": nrm(ks[14], (N_B, HEAD_DIM), 0.1),
        "b_subln": gain(ks[15], (N_B, 2 * HEAD_DIM)),
        "b_w_out": nrm(ks[16], (N_B, B_WIDTH, D_MODEL), B_WIDTH ** -0.5),
    }


def reference(x_prompt, x_sample, a_norm, a_w_in, a_q_norm, a_k_norm, a_w_out,
              b_norm, b_w_in, b_q_norm, b_k_norm, b_lambda_q1, b_lambda_k1,
              b_lambda_q2, b_lambda_k2, b_subln, b_w_out):
    y_prompt = run_trunk(x_prompt, a_norm, a_w_in, a_q_norm, a_k_norm, a_w_out,
                         b_norm, b_w_in, b_q_norm, b_k_norm, b_lambda_q1, b_lambda_k1,
                         b_lambda_q2, b_lambda_k2, b_subln, b_w_out)
    y_sample = run_trunk(x_sample, a_norm, a_w_in, a_q_norm, a_k_norm, a_w_out,
                         b_norm, b_w_in, b_q_norm, b_k_norm, b_lambda_q1, b_lambda_k1,
                         b_lambda_q2, b_lambda_k2, b_subln, b_w_out)
    return (y_prompt, y_sample)
```

```cpp
#include <hip/hip_runtime.h>
#include <hip/hip_cooperative_groups.h>
#include <cstdio>
#include <cstdint>
namespace cg = cooperative_groups;

#ifndef MK_N_LAUNCHES
#define MK_N_LAUNCHES 1
#endif

constexpr int DM = 2048, MP = 32768, MS = 16384, M = MP + MS, SEQ_P = 4096, SEQ_S = 8192;
constexpr int A_IN = 5120, B_IN = 8192, NPHASE = 20;
constexpr float EPS = 1e-6f;
constexpr size_t MiB = 1u << 20;
constexpr size_t WS_WIN = 0, WS_WOUT = 32 * MiB, WS_XN = 40 * MiB, WS_PROJ = 232 * MiB, WS_STASH = 1000 * MiB, WS_CTL = 1016 * MiB, WS_END = 1016 * MiB + 4096;
constexpr int LDS_BYTES = 163840;

#define LAS __attribute__((address_space(3)))
typedef unsigned short bf16_t;
typedef short bf16x8 __attribute__((ext_vector_type(8)));
typedef short s16x4 __attribute__((ext_vector_type(4)));
typedef float f32x4 __attribute__((ext_vector_type(4)));
typedef float f32x16 __attribute__((ext_vector_type(16)));
typedef unsigned u32x4 __attribute__((ext_vector_type(4)));
typedef unsigned u32x2 __attribute__((ext_vector_type(2)));

__device__ __forceinline__ unsigned cvtpk(float lo, float hi) { unsigned r; asm volatile("v_cvt_pk_bf16_f32 %0, %1, %2" : "=v"(r) : "v"(lo), "v"(hi)); return r; }
typedef int i32x8 __attribute__((ext_vector_type(8)));
typedef int i32x4 __attribute__((ext_vector_type(4)));
__device__ __forceinline__ unsigned pk4_fp8(float a, float b, float c, float d) { int p = __builtin_amdgcn_cvt_pk_fp8_f32(a, b, 0, false); return (unsigned)__builtin_amdgcn_cvt_pk_fp8_f32(c, d, p, true); }
constexpr float F8_WSCALE = 64.f, F8_ASCALE = 64.f;
typedef __bf16 bf16v2 __attribute__((ext_vector_type(2)));
typedef float f32x2 __attribute__((ext_vector_type(2)));
__device__ __forceinline__ unsigned cvtpk2(float lo, float hi) { return __builtin_bit_cast(unsigned, __builtin_convertvector((f32x2){lo, hi}, bf16v2)); }
__device__ __forceinline__ float bf2f(bf16_t b) { return __uint_as_float((unsigned)b << 16); }
__device__ __forceinline__ bf16_t f2bf(float f) { return (bf16_t)(cvtpk(f, 0.f) & 0xffffu); }
__device__ __forceinline__ float silu_f(float z) { return z * __builtin_amdgcn_rcpf(1.f + __builtin_amdgcn_exp2f(-1.4426950408889634f * z)); }
#define LDS_WAIT() asm volatile("s_waitcnt lgkmcnt(0)" ::: "memory")
__device__ __forceinline__ int fresh_lane() { int l; asm volatile("v_mbcnt_lo_u32_b32 %0, -1, 0\n\tv_mbcnt_hi_u32_b32 %0, -1, %0" : "=v"(l)); return l; }
template <int X> __device__ __forceinline__ float swz_xor(float v) { return __int_as_float(__builtin_amdgcn_ds_swizzle(__float_as_int(v), (X << 10) | 0x1f)); }
__device__ __forceinline__ float wave_sum(float v) {
  v += swz_xor<1>(v); v += swz_xor<2>(v); v += swz_xor<4>(v); v += swz_xor<8>(v); v += swz_xor<16>(v);
  auto rr = __builtin_amdgcn_permlane32_swap(__float_as_uint(v), __float_as_uint(v), false, false);
  return __uint_as_float(rr[0]) + __uint_as_float(rr[1]);
}

namespace pg8 {
#define PG8_LAS __attribute__((address_space(3)))
constexpr int BM = 256, BK = 64, HALF = 128, HTB = HALF * BK * 2, STAGE_BYTES = 8 * HTB, NXCD = 8, WGM = 8;
__host__ __device__ __forceinline__ int lds_byte(int r, int c) { const int st = (r >> 4) * 2 + (c >> 5), rr = r & 15, cc = c & 31, ob = rr * 64 + cc * 2; return st * 1024 + (ob ^ (((ob >> 9) & 1) << 5)); }
__host__ __device__ __forceinline__ void stage_rc(int b, int& R, int& C) { const int st = b / 1024, sb = b % 1024, swz = sb ^ (((sb >> 9) & 1) << 5); R = (st >> 1) * 16 + swz / 64; C = (st & 1) * 32 + (swz % 64) / 2; }
__host__ __device__ __forceinline__ int perm32(int rho) { const int n = rho >> 4, i = rho & 15; return 8 * (i >> 2) + 4 * n + (i & 3); }
struct Unit { int pm, pn; };
struct Gemm { const bf16_t* A; const bf16_t* Bt; int M, N, K; };
struct StaticOrder {
    int nM, nN, nwg, G, c;
    __host__ __device__ void init(int M_, int N_, int G_, int c_) { nM = M_ / BM; nN = N_ / BM; nwg = nM * nN; G = G_; c = c_; }
    __host__ __device__ bool next(int i, Unit& u) const {
        const long L = (long)i * G + c; if (L >= nwg) return false;
        int wgid = (int)L; { const int q = nwg / NXCD, r = nwg % NXCD, xcd = wgid % NXCD, off = wgid / NXCD; wgid = (xcd < r ? xcd * (q + 1) : r * (q + 1) + (xcd - r) * q) + off; }
        const int nig = WGM * nN, gid = wgid / nig, fm = gid * WGM, gsz = (nM - fm) < WGM ? (nM - fm) : WGM;
        u.pm = fm + ((wgid % nig) % gsz); u.pn = (wgid % nig) / gsz; return true;
    }
    __device__ __forceinline__ void a_ready(const Unit&) const {}
    __device__ __forceinline__ void done(const Unit&) const {}
};
struct EpiBf16 {
    static constexpr bool PERM = true, AFTER_DRAIN = false;
    bf16_t* O; int ldc; float scale;
    __device__ __forceinline__ void operator()(const f32x4 (&acc)[2][2][4][2], const Unit& u, int wr, int wc, int fr, int fq) const {
        const int row0 = u.pm * BM + wr * 64 + fr; const int col0 = u.pn * BM + wc * 32 + 8 * fq;
#pragma unroll
        for (int ai = 0; ai < 2; ++ai)
#pragma unroll
            for (int m = 0; m < 4; ++m) { bf16_t* rowp = O + (size_t)(row0 + ai * HALF + m * 16) * ldc + col0;
#pragma unroll
                for (int bj = 0; bj < 2; ++bj) { const f32x4 v0 = acc[ai][bj][m][0] * scale, v1 = acc[ai][bj][m][1] * scale;
                    u32x4 w; w.x = cvtpk(v0[0], v0[1]); w.y = cvtpk(v0[2], v0[3]); w.z = cvtpk(v1[0], v1[1]); w.w = cvtpk(v1[2], v1[3]);
                    *(u32x4*)(rowp + bj * HALF) = w; } }
    }
};
struct EpiResid {
    static constexpr bool PERM = false, AFTER_DRAIN = false;
    const float* baseP; const float* baseS; float* out; float scale;
    __device__ __forceinline__ void operator()(const f32x4 (&acc)[2][2][4][2], const Unit& u, int wr, int wc, int fr, int fq) const {
        const int rowt = u.pm * BM;
        const float* base = (rowt < MP ? baseP + (size_t)rowt * DM : baseS + (size_t)(rowt - MP) * DM) + u.pn * BM;
        float* o = out + (size_t)rowt * DM + u.pn * BM;
        unsigned lo = (unsigned)((wr * 64 + fr) * DM + wc * 32 + 4 * fq); asm volatile("" : "+v"(lo));
#pragma unroll
        for (int ai = 0; ai < 2; ++ai)
#pragma unroll
            for (int m = 0; m < 4; ++m) { const unsigned off = lo + (unsigned)((ai * HALF + m * 16) * DM);
#pragma unroll
                for (int bj = 0; bj < 2; ++bj) {
                    const f32x4 b0 = *(const f32x4*)(base + off + bj * HALF), b1 = *(const f32x4*)(base + off + bj * HALF + 16);
                    *(f32x4*)(o + off + bj * HALF) = b0 + acc[ai][bj][m][0] * scale; *(f32x4*)(o + off + bj * HALF + 16) = b1 + acc[ai][bj][m][1] * scale; }
                asm volatile("" ::: "memory"); }
    }
};

template <class Epi, class Sched, bool ALIGN_EPI = false, bool SP2 = false, bool F8 = false>
__device__ __forceinline__ void gemm_phase(PG8_LAS unsigned char* lds, const Gemm g, const Sched& S, const Epi& E, const int tid) {
    const int wid = __builtin_amdgcn_readfirstlane(tid >> 6), lane = tid & 63, wr = wid >> 2, wc = wid & 3, fr = lane & 15, fq = lane >> 4;
    const int K = g.K, nt = K / BK;
    unsigned voffA[2], voffB[2];
#pragma unroll
    for (int i = 0; i < 2; ++i) { int R, C; stage_rc(tid * 16 + i * 8192, R, C); const int Rb = Epi::PERM ? ((R & ~31) + perm32(R & 31)) : R;
        voffA[i] = (unsigned)(R * K + C) * 2u; voffB[i] = (unsigned)(Rb * K + C) * 2u; }
    const size_t kstep = (size_t)(BK * 2);
    const size_t hstep = (size_t)HALF * K * 2;
    const size_t tstep = 2 * hstep;
    const unsigned ldsw = (unsigned)wid * 1024u;
    const int aoff = lds_byte(wr * 64 + fr, fq * 8), boff = lds_byte(wc * 32 + fr, fq * 8);
#define PG8_SA(b, h) (((b) * 2 + (h)) * HTB)
#define PG8_SB(b, h) ((4 + (b) * 2 + (h)) * HTB)
#define PG8_STAGE(bufoff, gbase, voff) do { _Pragma("unroll") for (int _i = 0; _i < 2; ++_i) \
        __builtin_amdgcn_global_load_lds((const unsigned*)((const char*)(gbase) + (voff)[_i]), (PG8_LAS unsigned*)(lds + (bufoff) + ldsw + _i * 8192), 16, 0, 0); } while (0)
#define PG8_LDA(dst, b, h) do { _Pragma("unroll") for (int m = 0; m < 4; ++m) { if constexpr (F8) { dst##8[m].lo = *(const PG8_LAS i32x4*)(lds + PG8_SA(b, h) + aoff + m * 2048); dst##8[m].hi = *(const PG8_LAS i32x4*)(lds + PG8_SA(b, h) + aoff + m * 2048 + 1024); } \
        else { _Pragma("unroll") for (int k = 0; k < 2; ++k) dst[m][k] = *(const PG8_LAS bf16x8*)(lds + PG8_SA(b, h) + aoff + m * 2048 + k * 1024); } } } while (0)
#define PG8_LDB(dst, b, h) do { _Pragma("unroll") for (int n = 0; n < 2; ++n) { if constexpr (F8) { dst##8[n].lo = *(const PG8_LAS i32x4*)(lds + PG8_SB(b, h) + boff + n * 2048); dst##8[n].hi = *(const PG8_LAS i32x4*)(lds + PG8_SB(b, h) + boff + n * 2048 + 1024); } \
        else { _Pragma("unroll") for (int k = 0; k < 2; ++k) dst[n][k] = *(const PG8_LAS bf16x8*)(lds + PG8_SB(b, h) + boff + n * 2048 + k * 1024); } } } while (0)
#define PG8_MMA(ai, bj, At, Bt) do { __builtin_amdgcn_s_setprio(1); _Pragma("unroll") for (int m = 0; m < 4; ++m) _Pragma("unroll") for (int n = 0; n < 2; ++n) {                          \
        if constexpr (F8) asm volatile("v_mfma_scale_f32_16x16x128_f8f6f4 %0, %1, %2, %0, %3, %3 op_sel_hi:[0,0,0]" : "+v"(acc[ai][bj][m][n]) : "v"(Bt##8[n]), "v"(At##8[m]), "v"(f8one));    \
        else { _Pragma("unroll") for (int k = 0; k < 2; ++k) acc[ai][bj][m][n] = __builtin_amdgcn_mfma_f32_16x16x32_bf16(Bt[n][k], At[m][k], acc[ai][bj][m][n], 0, 0, 0); } }        \
        __builtin_amdgcn_s_setprio(0); } while (0)
#define PG8_WAIT_V(n) asm volatile("s_waitcnt vmcnt(" #n ")" ::: "memory")
#define PG8_WAIT_L(n) asm volatile("s_waitcnt lgkmcnt(" #n ")" ::: "memory")
#define PG8_BAR __builtin_amdgcn_s_barrier()
#define PG8_SCHED __builtin_amdgcn_sched_barrier(0)
    Unit cur, nxt; int ui = 0;
    if (!S.next(0, cur)) return;
    f32x4 acc[2][2][4][2];
#pragma unroll
    for (int a = 0; a < 2; ++a)
#pragma unroll
        for (int b = 0; b < 2; ++b)
#pragma unroll
            for (int m = 0; m < 4; ++m)
#pragma unroll
                for (int n = 0; n < 2; ++n) acc[a][b][m][n] = (f32x4){0.f, 0.f, 0.f, 0.f};
    int f8one = 0x7F7F7F7F; asm volatile("" : "+v"(f8one));
    bf16x8 At[4][2], B0[2][2], B1[2][2]; i32x8 At8[4], B08[2], B18[2];
    const char* cA = (const char*)g.A + (size_t)cur.pm * tstep; const char* cB = (const char*)g.Bt + (size_t)cur.pn * tstep;
    S.a_ready(cur);
    if constexpr (SP2) {
        PG8_STAGE(PG8_SB(0, 0), cB, voffB); PG8_STAGE(PG8_SB(0, 1), cB + hstep, voffB); PG8_STAGE(PG8_SA(0, 0), cA, voffA); PG8_STAGE(PG8_SA(0, 1), cA + hstep, voffA);
        if (wr == 1) PG8_BAR;
        PG8_WAIT_V(2); PG8_BAR;
        PG8_STAGE(PG8_SB(1, 0), cB + kstep, voffB); PG8_STAGE(PG8_SA(1, 0), cA + kstep, voffA); PG8_STAGE(PG8_SB(1, 1), cB + hstep + kstep, voffB);
        PG8_WAIT_V(6); PG8_BAR;
    } else {
        PG8_STAGE(PG8_SB(0, 0), cB, voffB); PG8_STAGE(PG8_SA(0, 0), cA, voffA); PG8_STAGE(PG8_SB(0, 1), cB + hstep, voffB); PG8_STAGE(PG8_SA(0, 1), cA + hstep, voffA);
        if (wr == 1) PG8_BAR;
        PG8_WAIT_V(4); PG8_BAR;
        PG8_STAGE(PG8_SB(1, 0), cB + kstep, voffB); PG8_STAGE(PG8_SA(1, 0), cA + kstep, voffA); PG8_STAGE(PG8_SB(1, 1), cB + hstep + kstep, voffB);
        PG8_WAIT_V(6); PG8_BAR;
    }
    for (;;) {
        const bool has_next = S.next(ui + 1, nxt);
        const char* nA = has_next ? (const char*)g.A + (size_t)nxt.pm * tstep : cA; const char* nB = has_next ? (const char*)g.Bt + (size_t)nxt.pn * tstep : cB;
        for (int t = 0; t < nt; t += 2) {
            const bool last = (t == nt - 2);
            const char* a1 = cA + (size_t)(t + 1) * kstep;
            const char* a2 = last ? nA : cA + (size_t)(t + 2) * kstep; const char* b2 = last ? nB : cB + (size_t)(t + 2) * kstep;
            const char* a3 = a2 + kstep; const char* b3 = b2 + kstep;
            if (last && has_next) S.a_ready(nxt);
            if constexpr (SP2) {
            PG8_LDB(B0, 0, 0); PG8_LDB(B1, 0, 1); PG8_SCHED; PG8_LDA(At, 0, 0); PG8_STAGE(PG8_SA(1, 1), a1 + hstep, voffA);
            PG8_WAIT_V(8); PG8_WAIT_L(0); PG8_BAR; PG8_MMA(0, 0, At, B0); PG8_MMA(0, 1, At, B1); PG8_BAR; PG8_SCHED;
            PG8_LDA(At, 0, 1); PG8_STAGE(PG8_SB(0, 0), b2, voffB); PG8_STAGE(PG8_SB(0, 1), b2 + hstep, voffB); PG8_STAGE(PG8_SA(0, 0), a2, voffA);
            PG8_WAIT_V(8); PG8_WAIT_L(0); PG8_BAR; PG8_MMA(1, 0, At, B0); PG8_MMA(1, 1, At, B1); PG8_BAR; PG8_SCHED;
            PG8_LDB(B0, 1, 0); PG8_LDB(B1, 1, 1); PG8_SCHED; PG8_LDA(At, 1, 0); PG8_STAGE(PG8_SA(0, 1), a2 + hstep, voffA);
            PG8_WAIT_V(8); PG8_WAIT_L(0); PG8_BAR; PG8_MMA(0, 0, At, B0); PG8_MMA(0, 1, At, B1); PG8_BAR; PG8_SCHED;
            PG8_LDA(At, 1, 1); PG8_STAGE(PG8_SB(1, 0), b3, voffB); PG8_STAGE(PG8_SB(1, 1), b3 + hstep, voffB); PG8_STAGE(PG8_SA(1, 0), a3, voffA);
            PG8_WAIT_V(8); PG8_WAIT_L(0); PG8_BAR; PG8_MMA(1, 0, At, B0); PG8_MMA(1, 1, At, B1); PG8_BAR; PG8_SCHED;
            } else {
            PG8_LDB(B0, 0, 0); PG8_SCHED; PG8_LDA(At, 0, 0); PG8_STAGE(PG8_SA(1, 1), a1 + hstep, voffA);
            PG8_WAIT_L(8); PG8_BAR; PG8_WAIT_L(0); PG8_MMA(0, 0, At, B0); PG8_BAR; PG8_SCHED;
            PG8_LDB(B1, 0, 1); PG8_STAGE(PG8_SB(0, 0), b2, voffB);
            PG8_BAR; PG8_WAIT_L(0); PG8_MMA(0, 1, At, B1); PG8_BAR;
            PG8_LDA(At, 0, 1); PG8_STAGE(PG8_SA(0, 0), a2, voffA);
            PG8_BAR; PG8_WAIT_L(0); PG8_MMA(1, 0, At, B0); PG8_BAR; PG8_SCHED;
            PG8_STAGE(PG8_SB(0, 1), b2 + hstep, voffB);
            PG8_WAIT_V(6); PG8_BAR; PG8_MMA(1, 1, At, B1); PG8_BAR;
            PG8_LDB(B0, 1, 0); PG8_SCHED; PG8_LDA(At, 1, 0); PG8_STAGE(PG8_SA(0, 1), a2 + hstep, voffA);
            PG8_WAIT_L(8); PG8_BAR; PG8_WAIT_L(0); PG8_MMA(0, 0, At, B0); PG8_BAR; PG8_SCHED;
            PG8_LDB(B1, 1, 1); PG8_STAGE(PG8_SB(1, 0), b3, voffB);
            PG8_BAR; PG8_WAIT_L(0); PG8_MMA(0, 1, At, B1); PG8_BAR;
            PG8_LDA(At, 1, 1); PG8_STAGE(PG8_SA(1, 0), a3, voffA);
            PG8_BAR; PG8_WAIT_L(0); PG8_MMA(1, 0, At, B0); PG8_BAR; PG8_SCHED;
            PG8_STAGE(PG8_SB(1, 1), b3 + hstep, voffB);
            PG8_WAIT_V(6); PG8_BAR; PG8_MMA(1, 1, At, B1); PG8_BAR;
            }
        }
        if constexpr (ALIGN_EPI) { if (wr == 0) PG8_BAR; }
        if constexpr (F8) asm volatile("s_nop 15\n\ts_nop 15" ::: "memory");
        if constexpr (!Epi::AFTER_DRAIN) { E(acc, cur, wr, wc, fr, fq); S.done(cur); }
        if (!has_next) break;
#pragma unroll
        for (int a = 0; a < 2; ++a)
#pragma unroll
            for (int b = 0; b < 2; ++b)
#pragma unroll
                for (int m = 0; m < 4; ++m)
#pragma unroll
                    for (int n = 0; n < 2; ++n) acc[a][b][m][n] = (f32x4){0.f, 0.f, 0.f, 0.f};
        cur = nxt; cA = nA; cB = nB; ++ui;
        if constexpr (ALIGN_EPI) { if (wr == 1) PG8_BAR; }
    }
    PG8_WAIT_V(0);
    if constexpr (!ALIGN_EPI) { if (wr == 0) PG8_BAR; }
    PG8_BAR;
#undef PG8_SA
#undef PG8_SB
#undef PG8_STAGE
#undef PG8_LDA
#undef PG8_LDB
#undef PG8_MMA
#undef PG8_WAIT_V
#undef PG8_WAIT_L
#undef PG8_BAR
#undef PG8_SCHED
}
}

namespace att {
constexpr int D = 128, NW = 8, QBLK = 32, KVBLK = 64;
constexpr float SCALE = 0.088388347648318440f;
constexpr float THR = 8.f;
constexpr size_t SHM_V = KVBLK * D * 2, SHM_K = KVBLK * D * 2, SHM_ATTN = 2 * SHM_V + 2 * SHM_K + NW * 64 * 4;
constexpr size_t STASH_OFF = SHM_ATTN, STASH_BYTES = 65536, SSQ_OFF = STASH_OFF + STASH_BYTES;
#define KSWZ(row, colB) ((row) * 256 + ((colB) ^ (((row) & 7) << 4)))
#define SBAR() __builtin_amdgcn_sched_barrier(0)
__device__ __forceinline__ int crow(int r, int hi) { return (r & 3) + 8 * (r >> 2) + 4 * hi; }
__device__ __forceinline__ bf16x8 ld8(const bf16_t* p) { return *reinterpret_cast<const bf16x8*>(p); }

__device__ __forceinline__ void partialSM(f32x16& p0, f32x16& p1, float& m_reg, float& mn, float& alpha) {
  constexpr float C = SCALE * 1.4426950408889634f;
  float pmax = p0[0]; for (int r = 1; r < 16; ++r) pmax = fmaxf(pmax, p0[r]); for (int r = 0; r < 16; ++r) pmax = fmaxf(pmax, p1[r]);
  { auto rr = __builtin_amdgcn_permlane32_swap(__float_as_uint(pmax), __float_as_uint(pmax), false, false);
    pmax = fmaxf(__uint_as_float(rr[0]), __uint_as_float(rr[1])); }
  if (__builtin_expect(__all(pmax - m_reg <= THR / SCALE), 1)) { mn = m_reg; alpha = 1.f; }
  else { mn = fmaxf(m_reg, pmax); alpha = __builtin_amdgcn_exp2f((m_reg - mn) * C); m_reg = mn; }
  float mnC = -mn * C;
  for (int r = 0; r < 16; ++r) p0[r] = fmaf(p0[r], C, mnC); for (int r = 0; r < 16; ++r) p1[r] = fmaf(p1[r], C, mnC);
  for (int r = 0; r < 16; ++r) p0[r] = __builtin_amdgcn_exp2f(p0[r]);
}
__device__ __forceinline__ void finishSM(f32x16& p0, f32x16& p1, float alpha, float& l_reg, bf16x8& pa0, bf16x8& pa1, bf16x8& pa2, bf16x8& pa3) {
  for (int r = 0; r < 16; ++r) p1[r] = __builtin_amdgcn_exp2f(p1[r]);
  float ps = 0; for (int r = 0; r < 16; ++r) ps += p0[r]; for (int r = 0; r < 16; ++r) ps += p1[r];
  { auto rr = __builtin_amdgcn_permlane32_swap(__float_as_uint(ps), __float_as_uint(ps), false, false);
    ps = __uint_as_float(rr[0]) + __uint_as_float(rr[1]); }
  l_reg = l_reg * alpha + ps;
#define PK4(P, BASE, OUT) do { unsigned a0 = cvtpk(P[BASE + 0], P[BASE + 1]), a1 = cvtpk(P[BASE + 2], P[BASE + 3]);   \
    unsigned b0 = cvtpk(P[BASE + 4], P[BASE + 5]), b1 = cvtpk(P[BASE + 6], P[BASE + 7]);                              \
    auto r0 = __builtin_amdgcn_permlane32_swap(a0, b0, false, false); auto r1 = __builtin_amdgcn_permlane32_swap(a1, b1, false, false); \
    u32x4 w = {r0[0], r1[0], r0[1], r1[1]}; OUT = *reinterpret_cast<bf16x8*>(&w); } while (0)
  PK4(p0, 0, pa0); PK4(p0, 8, pa1); PK4(p1, 0, pa2); PK4(p1, 8, pa3);
#undef PK4
}
__device__ __forceinline__ void qkt(f32x16& p0, f32x16& p1, const bf16_t* Ks, const bf16x8* qr, int r32, int hi) {
  p0 = f32x16{}; p1 = f32x16{};
  for (int d0 = 0; d0 < 8; ++d0) { int cb = (d0 * 16 + hi * 8) * 2;
    bf16x8 b0 = *reinterpret_cast<const bf16x8*>((const char*)Ks + KSWZ(r32, cb));
    bf16x8 b1 = *reinterpret_cast<const bf16x8*>((const char*)Ks + KSWZ(32 + r32, cb));
    p0 = __builtin_amdgcn_mfma_f32_32x32x16_bf16(b0, qr[d0], p0, 0, 0, 0);
    p1 = __builtin_amdgcn_mfma_f32_32x32x16_bf16(b1, qr[d0], p1, 0, 0, 0); }
}
__device__ __forceinline__ void qkt2(f32x16& p0, f32x16& p1, const int kbase, const bf16x8* qr, int r32, int hi, const f32x16& init) {
  int sw = (r32 & 7) << 4; asm volatile("" : "+v"(sw));
  const int rowb = kbase + r32 * 256 + hi * 16;
#pragma unroll
  for (int d = 0; d < 4; ++d) {
    const int a = kbase + r32 * 256 + ((d * 32 + hi * 16) ^ sw); (void)rowb;
    const bf16x8 b00 = *(const LAS bf16x8*)(unsigned)(a), b01 = *(const LAS bf16x8*)(unsigned)(a + 8192);
    const bf16x8 b10 = *(const LAS bf16x8*)(unsigned)(a + 128), b11 = *(const LAS bf16x8*)(unsigned)(a + 128 + 8192);
    p0 = __builtin_amdgcn_mfma_f32_32x32x16_bf16(b00, qr[d], d == 0 ? init : p0, 0, 0, 0);
    p1 = __builtin_amdgcn_mfma_f32_32x32x16_bf16(b01, qr[d], d == 0 ? init : p1, 0, 0, 0);
    p0 = __builtin_amdgcn_mfma_f32_32x32x16_bf16(b10, qr[d + 4], p0, 0, 0, 0);
    p1 = __builtin_amdgcn_mfma_f32_32x32x16_bf16(b11, qr[d + 4], p1, 0, 0, 0); }
}
__device__ __forceinline__ int v_st(int k, int c) { const int kk = (k & ~0xC) | ((k & 4) << 1) | ((k & 8) >> 1); return ((kk >> 3) * 4 + (c >> 5)) * 512 + ((kk & 7) * 32 + (c & 31)) * 2; }
__device__ __forceinline__ int v_rd_base(int lane) { return ((lane & 3) << 3) | (((lane >> 2) & 3) << 6) | (((lane >> 4) & 1) << 5) | (((lane >> 5) & 1) << 8); }
constexpr int v_rd_off(int d0, int ks, int half) { return d0 * 512 + ks * 4096 + half * 2048; }
template <int OFF> __device__ __forceinline__ bf16x8 lds_rd128(int a) {
  bf16x8 r; asm volatile("ds_read_b128 %0, %1 offset:%2" : "=&v"(r) : "v"(a), "i"(OFF) : "memory"); return r;
}
template <int OFF> __device__ __forceinline__ s16x4 tr_read(int vb) {
  s16x4 r; asm volatile("ds_read_b64_tr_b16 %0, %1 offset:%2" : "=&v"(r) : "v"(vb), "i"(OFF) : "memory"); return r;
}
template <int D0> __device__ __forceinline__ void pv_one(f32x16& od, int vb, bf16x8 pa0, bf16x8 pa1, bf16x8 pa2, bf16x8 pa3) {
  const s16x4 l0 = tr_read<v_rd_off(D0, 0, 0)>(vb), h0 = tr_read<v_rd_off(D0, 0, 1)>(vb), l1 = tr_read<v_rd_off(D0, 1, 0)>(vb), h1 = tr_read<v_rd_off(D0, 1, 1)>(vb);
  const s16x4 l2 = tr_read<v_rd_off(D0, 2, 0)>(vb), h2 = tr_read<v_rd_off(D0, 2, 1)>(vb), l3 = tr_read<v_rd_off(D0, 3, 0)>(vb), h3 = tr_read<v_rd_off(D0, 3, 1)>(vb);
  asm volatile("s_waitcnt lgkmcnt(0)" ::: "memory"); SBAR();
#define PK(L, H) (bf16x8){L[0], L[1], L[2], L[3], H[0], H[1], H[2], H[3]}
  od = __builtin_amdgcn_mfma_f32_32x32x16_bf16(pa0, PK(l0, h0), od, 0, 0, 0);
  od = __builtin_amdgcn_mfma_f32_32x32x16_bf16(pa1, PK(l1, h1), od, 0, 0, 0);
  od = __builtin_amdgcn_mfma_f32_32x32x16_bf16(pa2, PK(l2, h2), od, 0, 0, 0);
  od = __builtin_amdgcn_mfma_f32_32x32x16_bf16(pa3, PK(l3, h3), od, 0, 0, 0);
#undef PK
}
__device__ __forceinline__ void pv_d0(f32x16* o, int vb, bf16x8 pa0, bf16x8 pa1, bf16x8 pa2, bf16x8 pa3) {
  pv_one<0>(o[0], vb, pa0, pa1, pa2, pa3); pv_one<1>(o[1], vb, pa0, pa1, pa2, pa3); pv_one<2>(o[2], vb, pa0, pa1, pa2, pa3); pv_one<3>(o[3], vb, pa0, pa1, pa2, pa3);
}

template <int LDQ, int LDK, class Epi>
__device__ __forceinline__ void attn_dense_body(const bf16_t* __restrict__ Qb, const bf16_t* __restrict__ Kh, const bf16_t* __restrict__ Vh,
                                                int seq, char* lds, const Epi& epi, const int wv) {
  constexpr int SDEPTH = 2;
  const int tid = wv * 64 + fresh_lane();
  const int wid = wv, lane = tid & 63, r32 = lane & 31, hi = lane >> 5;
  bf16_t* V_lds = (bf16_t*)lds; bf16_t* K_lds = (bf16_t*)(lds + 2 * SHM_V);
  float* ws = (float*)(lds + 2 * SHM_V + 2 * SHM_K) + wid * 64; float* li_l = ws; float* al_l = ws + 32;
  float m_reg = -1e30f, l_reg = 0; f32x16 o[4] = {}; bf16x8 qr[8];
  const bf16_t* Qw = Qb + (unsigned)((wid * QBLK + r32) * LDQ + hi * 8);
#pragma unroll
  for (int d0 = 0; d0 < 8; ++d0) qr[d0] = ld8(Qw + d0 * 16);
  const int sr = tid >> 4, sc = (tid & 15) * 8, vst0 = v_st(sr, sc), vst1 = v_st(32 + sr, sc);
  const int vb0 = (int)(uintptr_t)V_lds + v_rd_base(lane);
  struct { bf16x8 vs0, vs1, ks0, ks1; } sr_[SDEPTH];
  const unsigned soff = (unsigned)(sr * LDK + sc);
#define SLOAD(i, k0) do { const unsigned o0_ = soff + (unsigned)(k0) * LDK, o1_ = o0_ + 32u * LDK; sr_[i].vs0 = ld8(Vh + o0_); sr_[i].vs1 = ld8(Vh + o1_); \
    sr_[i].ks0 = ld8(Kh + o0_); sr_[i].ks1 = ld8(Kh + o1_); } while (0)
#define SWRITE(b, i) do { *(bf16x8*)((char*)V_lds + (b) * SHM_V + vst0) = sr_[i].vs0;          \
    *(bf16x8*)((char*)V_lds + (b) * SHM_V + vst1) = sr_[i].vs1; int kc = sc * 2;               \
    *(bf16x8*)((char*)K_lds + (b) * SHM_K + KSWZ(sr, kc)) = sr_[i].ks0;                       \
    *(bf16x8*)((char*)K_lds + (b) * SHM_K + KSWZ(32 + sr, kc)) = sr_[i].ks1; } while (0)
#define SWAIT() do { asm volatile("s_waitcnt vmcnt(4)" ::: "memory"); } while (0)
#define RESC(a) do { if (__any((a) < 1.f)) { if (hi == 0) al_l[r32] = (a); asm volatile("s_waitcnt lgkmcnt(0)" ::: "memory"); \
    for (int d = 0; d < 4; ++d) for (int r = 0; r < 16; ++r) o[d][r] *= al_l[crow(r, hi)]; } } while (0)
  f32x16 pA0, pA1, pB0, pB1; float mnA, mnB, alA, alB; bf16x8 pa0, pa1, pa2, pa3; const int NT = seq / KVBLK;
  constexpr int SE = 0, SO = SDEPTH - 1;
  SLOAD(SE, 0); asm volatile("s_waitcnt vmcnt(0)" ::: "memory"); SWRITE(0, SE); __syncthreads();
  qkt(pA0, pA1, K_lds, qr, r32, hi); partialSM(pA0, pA1, m_reg, mnA, alA);
  SLOAD(SO, KVBLK); if (2 < NT) SLOAD(SE, 2 * KVBLK);
  SWAIT(); SWRITE(1, SO); __syncthreads();
  for (int j = 1; j + 1 < NT; j += 2) {
    SBAR(); qkt(pB0, pB1, (bf16_t*)((char*)K_lds + SHM_K), qr, r32, hi);
    finishSM(pA0, pA1, alA, l_reg, pa0, pa1, pa2, pa3); SBAR();
    SLOAD(SO, (j + SDEPTH) * KVBLK); SBAR();
    pv_d0(o, vb0, pa0, pa1, pa2, pa3); partialSM(pB0, pB1, m_reg, mnB, alB);
    __syncthreads(); SWAIT(); SWRITE(0, SE);
    RESC(alB); __syncthreads();
    SBAR(); qkt(pA0, pA1, K_lds, qr, r32, hi);
    finishSM(pB0, pB1, alB, l_reg, pa0, pa1, pa2, pa3); SBAR();
    if (j + 3 < NT) SLOAD(SE, (j + 1 + SDEPTH) * KVBLK); SBAR();
    pv_d0(o, vb0 + (int)SHM_V, pa0, pa1, pa2, pa3); partialSM(pA0, pA1, m_reg, mnA, alA);
    __syncthreads(); SWAIT(); SWRITE(1, SO);
    RESC(alA); __syncthreads();
  }
  SBAR(); qkt(pB0, pB1, (bf16_t*)((char*)K_lds + SHM_K), qr, r32, hi);
  finishSM(pA0, pA1, alA, l_reg, pa0, pa1, pa2, pa3); SBAR();
  pv_d0(o, vb0, pa0, pa1, pa2, pa3); partialSM(pB0, pB1, m_reg, mnB, alB);
  __syncthreads(); RESC(alB);
  finishSM(pB0, pB1, alB, l_reg, pa0, pa1, pa2, pa3); SBAR();
  pv_d0(o, vb0 + (int)SHM_V, pa0, pa1, pa2, pa3);
  if (hi == 0) li_l[r32] = l_reg; asm volatile("s_waitcnt lgkmcnt(0)" ::: "memory");
  float rli[16];
#pragma unroll
  for (int r = 0; r < 16; ++r) rli[r] = __builtin_amdgcn_rcpf(li_l[crow(r, hi)]);
  epi(o, rli, wid, r32, hi, lane);
#undef SLOAD
#undef SWRITE
#undef SWAIT
#undef RESC
}

struct EpiA {
  const bf16_t* z0;
  unsigned char* ao0;
  __device__ __forceinline__ void operator()(f32x16 (&o)[4], const float (&rli)[16], int wid, int r32, int hi, int lane) const {
    unsigned lb = (unsigned)(wid * QBLK + 4 * hi); asm volatile("" : "+v"(lb));
    const unsigned zo = lb * A_IN + r32, oo = lb * DM + r32;
#pragma unroll
    for (int r = 0; r < 16; ++r) { const unsigned cr = (r & 3) + 8 * (r >> 2);
#pragma unroll
      for (int d0 = 0; d0 < 4; ++d0) {
        const float z = bf2f(z0[zo + cr * A_IN + d0 * 32]);
        ao0[oo + cr * DM + d0 * 32] = (unsigned char)(__builtin_amdgcn_cvt_pk_fp8_f32(o[d0][r] * rli[r] * silu_f(z) * F8_ASCALE, 0.f, 0, false) & 0xff); } }
  }
};
struct EpiB {
  int c, vh; float lam, oscale;
  const bf16_t* z0;
  bf16_t* ao0;
  const float* sg;
  unsigned* stash;
  float* ssq;
  __device__ __forceinline__ void operator()(f32x16 (&o)[4], const float (&rli)[16], int wid, int r32, int hi, int lane) const {
    unsigned* st = stash + (wid * 32) * 64 + lane;
    if (c == 0) {
#pragma unroll
      for (int d0 = 0; d0 < 4; ++d0)
#pragma unroll
        for (int q = 0; q < 8; ++q) st[(d0 * 8 + q) * 64] = cvtpk(o[d0][2 * q] * rli[2 * q], o[d0][2 * q + 1] * rli[2 * q + 1]);
      return;
    }
    float ss[16];
#pragma unroll
    for (int r = 0; r < 16; ++r) ss[r] = 0.f;
#pragma unroll
    for (int d0 = 0; d0 < 4; ++d0)
#pragma unroll
      for (int q = 0; q < 8; ++q) { const unsigned u = st[(d0 * 8 + q) * 64];
        const float da = __uint_as_float(u << 16) - lam * (o[d0][2 * q] * rli[2 * q]);
        const float db = __uint_as_float(u & 0xffff0000u) - lam * (o[d0][2 * q + 1] * rli[2 * q + 1]);
        o[d0][2 * q] = da; o[d0][2 * q + 1] = db; ss[2 * q] += da * da; ss[2 * q + 1] += db * db; }
#pragma unroll
    for (int r = 0; r < 16; ++r) { ss[r] += swz_xor<1>(ss[r]); ss[r] += swz_xor<2>(ss[r]); ss[r] += swz_xor<4>(ss[r]); ss[r] += swz_xor<8>(ss[r]); ss[r] += swz_xor<16>(ss[r]); }
    float* sq = ssq + wid * 32 + 4 * hi;
    unsigned lb = (unsigned)(wid * QBLK + 4 * hi); asm volatile("" : "+v"(lb));
    const unsigned zo = lb * B_IN + r32, oo = lb * DM + r32;
    if (vh == 0) {
#pragma unroll
      for (int r = 0; r < 16; ++r) { const unsigned cr = (r & 3) + 8 * (r >> 2);
        if (r32 == 0) sq[cr] = ss[r];
#pragma unroll
        for (int d0 = 0; d0 < 4; ++d0) ao0[oo + cr * DM + d0 * 32] = f2bf(o[d0][r]); }
      return;
    }
    LDS_WAIT();
#pragma unroll
    for (int r = 0; r < 16; ++r) { const unsigned cr = (r & 3) + 8 * (r >> 2);
      const float rs = __builtin_amdgcn_rsqf((ss[r] + sq[cr]) * (1.f / 256.f) + EPS) * oscale;
#pragma unroll
      for (int d0 = 0; d0 < 4; ++d0) { const unsigned col = d0 * 32;
        const float z1 = bf2f(z0[zo + cr * B_IN + 128 + col]);
        ao0[oo + cr * DM + 128 + col] = f2bf(o[d0][r] * rs * sg[128 + col + r32] * silu_f(z1));
        const float dv = bf2f(ao0[oo + cr * DM + col]); const float z0v = bf2f(z0[zo + cr * B_IN + col]);
        ao0[oo + cr * DM + col] = f2bf(dv * rs * sg[col + r32] * silu_f(z0v)); } }
  }
};

template <bool AXIAL>
__device__ __forceinline__ void q_prep(bf16x8 (&qr)[8], const float* __restrict__ g, const int t, const int hi, const float* __restrict__ inv64, i32x8* qf = nullptr) {
  constexpr float QS = SCALE * 1.4426950408889634f, INV2PI = 0.15915494309189535f;
  float x[8][8]; float ss = 0.f;
#pragma unroll
  for (int d0 = 0; d0 < 8; ++d0)
#pragma unroll
    for (int k = 0; k < 8; ++k) { x[d0][k] = bf2f((bf16_t)qr[d0][k]); ss += x[d0][k] * x[d0][k]; }
  { auto rr = __builtin_amdgcn_permlane32_swap(__float_as_uint(ss), __float_as_uint(ss), false, false); ss = __uint_as_float(rr[0]) + __uint_as_float(rr[1]); }
  const float rs = __builtin_amdgcn_rsqf(ss * (1.f / 128.f) + EPS) * QS;
#pragma unroll
  for (int d0 = 0; d0 < 8; ++d0) { const f32x4 g0 = *(const f32x4*)(g + d0 * 16 + hi * 8), g1 = *(const f32x4*)(g + d0 * 16 + hi * 8 + 4);
#pragma unroll
    for (int k = 0; k < 4; ++k) { x[d0][k] *= rs * g0[k]; x[d0][4 + k] *= rs * g1[k]; } }
#pragma unroll
  for (int p = 0; p < 4; ++p) {
    const int da = AXIAL ? (p >> 1) * 4 + (p & 1) : p, db = AXIAL ? da + 2 : da + 4;
    const float pos = AXIAL ? (float)((p >> 1) ? (t & 63) : (t >> 6)) : (float)t;
#pragma unroll
    for (int k = 0; k < 8; ++k) {
      const int j = AXIAL ? 2 * ((p & 1) * 16 + hi * 8 + k) : p * 16 + hi * 8 + k;
      const float rev = __builtin_amdgcn_fractf(pos * (inv64[j] * INV2PI));
      const float c = __builtin_amdgcn_cosf(rev), s = __builtin_amdgcn_sinf(rev);
      const float a = x[da][k], b = x[db][k];
      x[da][k] = a * c - b * s; x[db][k] = b * c + a * s; } }
  if (qf) {
#pragma unroll
    for (int s = 0; s < 2; ++s)
#pragma unroll
      for (int c = 0; c < 4; ++c) { qf[s][2 * c] = (int)pk4_fp8(x[4 * s + c][0] * 8.f, x[4 * s + c][1] * 8.f, x[4 * s + c][2] * 8.f, x[4 * s + c][3] * 8.f);
        qf[s][2 * c + 1] = (int)pk4_fp8(x[4 * s + c][4] * 8.f, x[4 * s + c][5] * 8.f, x[4 * s + c][6] * 8.f, x[4 * s + c][7] * 8.f); }
    return; }
#pragma unroll
  for (int d0 = 0; d0 < 8; ++d0) { u32x4 w = {cvtpk2(x[d0][0], x[d0][1]), cvtpk2(x[d0][2], x[d0][3]), cvtpk2(x[d0][4], x[d0][5]), cvtpk2(x[d0][6], x[d0][7])}; qr[d0] = *reinterpret_cast<bf16x8*>(&w); }
}

constexpr size_t DV_OFF = 0, DK_OFF = 98304, DPX_OFF = 131072, DXL_OFF = DPX_OFF, DXS_OFF = DPX_OFF + 1024;
template <int D0> __device__ __forceinline__ void pv_split(f32x16& od, int vbo, int vbt, bf16x8 own0, bf16x8 own1, bf16x8 oth0, bf16x8 oth1) {
  const s16x4 l0 = tr_read<v_rd_off(D0, 0, 0)>(vbo), h0 = tr_read<v_rd_off(D0, 0, 1)>(vbo), l1 = tr_read<v_rd_off(D0, 1, 0)>(vbo), h1 = tr_read<v_rd_off(D0, 1, 1)>(vbo);
  const s16x4 l2 = tr_read<v_rd_off(D0, 0, 0)>(vbt), h2 = tr_read<v_rd_off(D0, 0, 1)>(vbt), l3 = tr_read<v_rd_off(D0, 1, 0)>(vbt), h3 = tr_read<v_rd_off(D0, 1, 1)>(vbt);
  asm volatile("s_waitcnt lgkmcnt(0)" ::: "memory"); SBAR();
#define PK(L, H) (bf16x8){L[0], L[1], L[2], L[3], H[0], H[1], H[2], H[3]}
  od = __builtin_amdgcn_mfma_f32_32x32x16_bf16(own0, PK(l0, h0), od, 0, 0, 0);
  od = __builtin_amdgcn_mfma_f32_32x32x16_bf16(own1, PK(l1, h1), od, 0, 0, 0);
  od = __builtin_amdgcn_mfma_f32_32x32x16_bf16(oth0, PK(l2, h2), od, 0, 0, 0);
  od = __builtin_amdgcn_mfma_f32_32x32x16_bf16(oth1, PK(l3, h3), od, 0, 0, 0);
#undef PK
}
struct EpiD {
  int c; float lam, oscale;
  const bf16_t* z0;
  bf16_t* ao0;
  const float* sg;
  unsigned* stash;
};
template <int LD>
__device__ __forceinline__ void attn_diff_body(const bf16_t* __restrict__ Qb, const bf16_t* __restrict__ Kh, const bf16_t* __restrict__ Vh,
                                               int seq, char* lds, const float nbC, const EpiD& epi, const int wv, const float* qg, const int t0, const float* inv64) {
  constexpr float C = SCALE * 1.4426950408889634f;
  const int lane = fresh_lane(), tid = wv * 64 + lane;
  const int rb = wv >> 1, kh = wv & 1, r32 = lane & 31, hi = lane >> 5;
  char* V_lds = lds + DV_OFF; char* K_lds = lds + DK_OFF; char* PX = lds + DPX_OFF;
  float* xl = (float*)(lds + DXL_OFF); float* xs = (float*)(lds + DXS_OFF);
  f32x16 o[4] = {}; bf16x8 qr[8]; float lsum = 0.f;
  const int vbase = (int)(uintptr_t)V_lds + kh * 16384 + v_rd_base(lane);
  const int vbo = vbase + kh * 8192, vbt = vbase + (1 - kh) * 8192;
  const int krow = (kh * 32 + r32);
  const int pxw = wv * 2048 + lane * 16, pxr = (wv ^ 1) * 2048 + lane * 16;
  const int krl = lane >> 4;
  const unsigned kof0 = (unsigned)((8 * wv + krl) * LD + (((lane & 15) ^ krl) * 8)) * 2u;
  const unsigned kof1 = (unsigned)((8 * wv + 4 + krl) * LD + (((lane & 15) ^ (4 + krl)) * 8)) * 2u;
  const int keyv = wv * 8 + ((lane & 31) >> 2);
  const unsigned vof = (unsigned)(keyv * LD + (lane >> 5) * 32 + (lane & 3) * 8) * 2u;
  LAS unsigned char* ldl = (LAS unsigned char*)lds;
#define DMA16(gp, lo) __builtin_amdgcn_global_load_lds((const unsigned*)(gp), (LAS unsigned*)(ldl + (lo)), 16, 0, 0)
#define DMA_TILE(t, kb, vo) do { const char* kg_ = (const char*)Kh + (size_t)(t) * (KVBLK * LD * 2); const char* vg_ = (const char*)Vh + (size_t)(t) * (KVBLK * LD * 2); \
    DMA16(kg_ + kof0, DK_OFF + (kb) * 16384 + wv * 2048); DMA16(kg_ + kof1, DK_OFF + (kb) * 16384 + wv * 2048 + 1024);                      \
    DMA16(vg_ + vof, DV_OFF + (vo) + wv * 2048); DMA16(vg_ + vof + 128, DV_OFF + (vo) + wv * 2048 + 1024);                                  \
    DMA16(vg_ + vof + 256, DV_OFF + (vo) + 16384 + wv * 2048); DMA16(vg_ + vof + 384, DV_OFF + (vo) + 16384 + wv * 2048 + 1024); } while (0)
#define WBAR(n) do { asm volatile("s_waitcnt vmcnt(" #n ") lgkmcnt(0)" ::: "memory"); __builtin_amdgcn_s_barrier(); asm volatile("" ::: "memory"); } while (0)
#define PK4(P, BASE, OUT) do { u32x4 w = {cvtpk2(P[BASE + 0], P[BASE + 1]), cvtpk2(P[BASE + 2], P[BASE + 3]), cvtpk2(P[BASE + 4], P[BASE + 5]), cvtpk2(P[BASE + 6], P[BASE + 7])}; \
    OUT = *reinterpret_cast<bf16x8*>(&w); } while (0)
#define EXPC(P, lo) do { _Pragma("unroll") for (int r = (lo); r < (lo) + 4; ++r) { P[r] = __builtin_amdgcn_exp2f(P[r]); lsum += P[r]; } } while (0)
#define PKW(p, o0, o1, b) do { PK4(p, 0, o0); PK4(p, 8, o1); *(bf16x8*)(PX + (b) * 16384 + pxw) = o0; *(bf16x8*)(PX + (b) * 16384 + pxw + 1024) = o1; } while (0)
#define KADDR() int sw_ = (r32 & 7) << 4; asm volatile("" : "+v"(sw_)); const int kr_ = kb0 + krow * 256;                                       \
    const int a0_ = kr_ + ((0 + hi * 16) ^ sw_), a1_ = kr_ + ((32 + hi * 16) ^ sw_), a2_ = kr_ + ((64 + hi * 16) ^ sw_), a3_ = kr_ + ((96 + hi * 16) ^ sw_)
#define KRD_LO(KB) do { kf[0] = lds_rd128<(KB) * 16384>(a0_); kf[1] = lds_rd128<(KB) * 16384>(a1_); kf[2] = lds_rd128<(KB) * 16384>(a2_); kf[3] = lds_rd128<(KB) * 16384>(a3_); } while (0)
#define KRD_HI(KB) do { kf[4] = lds_rd128<(KB) * 16384 + 128>(a0_); kf[5] = lds_rd128<(KB) * 16384 + 128>(a1_); kf[6] = lds_rd128<(KB) * 16384 + 128>(a2_); kf[7] = lds_rd128<(KB) * 16384 + 128>(a3_); } while (0)
#define QK1(p, d, n) do { asm volatile("s_waitcnt lgkmcnt(" #n ")" : "+v"(kf[d]) :: "memory"); p = __builtin_amdgcn_mfma_f32_32x32x16_bf16(kf[d], qr[d], (d) == 0 ? pinit : p, 0, 0, 0); } while (0)
#define TRB(T, D0, vo_, vt_) do { T[0] = tr_read<v_rd_off(D0, 0, 0)>(vo_); T[1] = tr_read<v_rd_off(D0, 0, 1)>(vo_); T[2] = tr_read<v_rd_off(D0, 1, 0)>(vo_); T[3] = tr_read<v_rd_off(D0, 1, 1)>(vo_); \
    T[4] = tr_read<v_rd_off(D0, 0, 0)>(vt_); T[5] = tr_read<v_rd_off(D0, 0, 1)>(vt_); T[6] = tr_read<v_rd_off(D0, 1, 0)>(vt_); T[7] = tr_read<v_rd_off(D0, 1, 1)>(vt_); } while (0)
#define TRW(T, n) asm volatile("s_waitcnt lgkmcnt(" #n ")" : "+v"(T[0]), "+v"(T[1]), "+v"(T[2]), "+v"(T[3]), "+v"(T[4]), "+v"(T[5]), "+v"(T[6]), "+v"(T[7]) :: "memory")
#define PKV(L, H) (bf16x8){L[0], L[1], L[2], L[3], H[0], H[1], H[2], H[3]}
#define MB(od, T, o0, o1, t0, t1) do { od = __builtin_amdgcn_mfma_f32_32x32x16_bf16(o0, PKV(T[0], T[1]), od, 0, 0, 0); od = __builtin_amdgcn_mfma_f32_32x32x16_bf16(o1, PKV(T[2], T[3]), od, 0, 0, 0); \
    od = __builtin_amdgcn_mfma_f32_32x32x16_bf16(t0, PKV(T[4], T[5]), od, 0, 0, 0); od = __builtin_amdgcn_mfma_f32_32x32x16_bf16(t1, PKV(T[6], T[7]), od, 0, 0, 0); } while (0)
#define STEP(KB, pn, o0, o1, n0, n1) do { const int vo_ = vbo + v0, vt_ = vbt + v0; KADDR();                                                    \
    ot0 = lds_rd128<(1 - (KB)) * 16384>(pxra); ot1 = lds_rd128<(1 - (KB)) * 16384 + 1024>(pxra); TRB(trA, 0, vo_, vt_); KRD_LO(KB);              \
    QK1(pn, 0, 3); QK1(pn, 1, 2); QK1(pn, 2, 1); QK1(pn, 3, 0);                                                                  \
    asm volatile("" : "+v"(ot0), "+v"(ot1) :: "memory"); TRW(trA, 0);                                      \
    KRD_HI(KB); TRB(trB, 1, vo_, vt_);                                                                                                          \
    QK1(pn, 4, 11); QK1(pn, 5, 10); QK1(pn, 6, 9); QK1(pn, 7, 8);                                                                               \
    MB(o[0], trA, o0, o1, ot0, ot1); EXPC(pn, 0); TRW(trB, 0); TRB(trA, 2, vo_, vt_);                                                           \
    MB(o[1], trB, o0, o1, ot0, ot1); EXPC(pn, 4); TRW(trA, 0); TRB(trB, 3, vo_, vt_);                                                           \
    MB(o[2], trA, o0, o1, ot0, ot1); EXPC(pn, 8); TRW(trB, 0);                                                                                 \
    MB(o[3], trB, o0, o1, ot0, ot1); EXPC(pn, 12);                                                                                             \
    PKW(pn, n0, n1, KB); } while (0)
  f32x16 pA, pB, pinit; bf16x8 ownA0, ownA1, ownB0, ownB1, ot0, ot1, kf[8]; s16x4 trA[8], trB[8]; const int NT = seq / KVBLK;
  { float nb_ = nbC; asm volatile("" : "+v"(nb_));
#pragma unroll
    for (int r = 0; r < 16; ++r) pinit[r] = nb_; }
  asm volatile("" : "+v"(pinit));
  const int kb0 = (int)(uintptr_t)K_lds, pxra = (int)(uintptr_t)PX + pxr;
  int v0 = 0, v1 = 32768, v2 = 65536;
  DMA_TILE(0, 0, 0); DMA_TILE(1, 1, 32768);
  { const bf16_t* Qw = Qb + (unsigned)((rb * QBLK + r32) * LD + hi * 8);
    _Pragma("unroll")
    for (int d0 = 0; d0 < 8; ++d0) qr[d0] = ld8(Qw + d0 * 16);
    q_prep<false>(qr, qg, t0 + rb * QBLK + r32, hi, inv64); }
  WBAR(0);
  { KADDR(); KRD_LO(0); KRD_HI(0); QK1(pA, 0, 7); QK1(pA, 1, 6); QK1(pA, 2, 5); QK1(pA, 3, 4); QK1(pA, 4, 3); QK1(pA, 5, 2); QK1(pA, 6, 1); QK1(pA, 7, 0); }
  EXPC(pA, 0); EXPC(pA, 4); EXPC(pA, 8); EXPC(pA, 12); PKW(pA, ownA0, ownA1, 0);
  WBAR(0);
  for (int j = 1; j + 1 < NT; j += 2) {
    DMA_TILE(j + 1, 0, v2);
    STEP(1, pB, ownA0, ownA1, ownB0, ownB1);
    WBAR(0);
    { const int t = v0; v0 = v1; v1 = v2; v2 = t; }
    DMA_TILE(j + 2, 1, v2);
    STEP(0, pA, ownB0, ownB1, ownA0, ownA1);
    WBAR(0);
    { const int t = v0; v0 = v1; v1 = v2; v2 = t; }
  }
  STEP(1, pB, ownA0, ownA1, ownB0, ownB1);
  WBAR(0);
  { const int vo_ = vbo + v1, vt_ = vbt + v1;
    ot0 = lds_rd128<16384>(pxra); ot1 = lds_rd128<16384 + 1024>(pxra);
    TRB(trA, 0, vo_, vt_);
    asm volatile("s_waitcnt lgkmcnt(0)" : "+v"(ot0), "+v"(ot1) :: "memory"); TRW(trA, 0); TRB(trB, 1, vo_, vt_);
    MB(o[0], trA, ownB0, ownB1, ot0, ot1); TRW(trB, 0); TRB(trA, 2, vo_, vt_);
    MB(o[1], trB, ownB0, ownB1, ot0, ot1); TRW(trA, 0); TRB(trB, 3, vo_, vt_);
    MB(o[2], trA, ownB0, ownB1, ot0, ot1); TRW(trB, 0);
    MB(o[3], trB, ownB0, ownB1, ot0, ot1); }
  WBAR(0);
#undef DMA16
#undef DMA_TILE
#undef WBAR
#undef PK4
#undef EXPC
#undef PKW
#undef KADDR
#undef KRD_LO
#undef KRD_HI
#undef QK1
#undef TRB
#undef TRW
#undef PKV
#undef MB
#undef STEP
  { auto rr = __builtin_amdgcn_permlane32_swap(__float_as_uint(lsum), __float_as_uint(lsum), false, false);
    lsum = __uint_as_float(rr[0]) + __uint_as_float(rr[1]); }
  if (hi == 0) xl[wv * 32 + r32] = lsum;
  __syncthreads();
  float rli[16];
#pragma unroll
  for (int r = 0; r < 16; ++r) { const int cr = crow(r, hi); rli[r] = __builtin_amdgcn_rcpf(xl[wv * 32 + cr] + xl[(wv ^ 1) * 32 + cr]); }
  unsigned* st = epi.stash + (wv * 32) * 64 + lane;
  if (epi.c == 0) {
#pragma unroll
    for (int d0 = 0; d0 < 4; ++d0)
#pragma unroll
      for (int q = 0; q < 8; ++q) st[(d0 * 8 + q) * 64] = cvtpk(o[d0][2 * q] * rli[2 * q], o[d0][2 * q + 1] * rli[2 * q + 1]);
    return;
  }
  float ss[16];
#pragma unroll
  for (int r = 0; r < 16; ++r) ss[r] = 0.f;
#pragma unroll
  for (int d0 = 0; d0 < 4; ++d0)
#pragma unroll
    for (int q = 0; q < 8; ++q) { const unsigned u = st[(d0 * 8 + q) * 64];
      const float da = __uint_as_float(u << 16) - epi.lam * (o[d0][2 * q] * rli[2 * q]);
      const float db = __uint_as_float(u & 0xffff0000u) - epi.lam * (o[d0][2 * q + 1] * rli[2 * q + 1]);
      o[d0][2 * q] = da; o[d0][2 * q + 1] = db; ss[2 * q] += da * da; ss[2 * q + 1] += db * db; }
#pragma unroll
  for (int r = 0; r < 16; ++r) { ss[r] += swz_xor<1>(ss[r]); ss[r] += swz_xor<2>(ss[r]); ss[r] += swz_xor<4>(ss[r]); ss[r] += swz_xor<8>(ss[r]); ss[r] += swz_xor<16>(ss[r]); }
  if (r32 == 0) {
#pragma unroll
    for (int r = 0; r < 16; ++r) xs[wv * 32 + crow(r, hi)] = ss[r]; }
  __syncthreads();
  unsigned lb = (unsigned)(rb * QBLK + 4 * hi); asm volatile("" : "+v"(lb));
  const unsigned zo = lb * LD + kh * 128 + r32, oo = lb * DM + kh * 128 + r32;
  const float* sgk = epi.sg + kh * 128 + r32;
#pragma unroll
  for (int r = 0; r < 16; ++r) { const unsigned cr = (r & 3) + 8 * (r >> 2);
    const float rs = __builtin_amdgcn_rsqf((ss[r] + xs[(wv ^ 1) * 32 + cr + 4 * hi]) * (1.f / 256.f) + EPS) * epi.oscale;
#pragma unroll
    for (int d0 = 0; d0 < 4; ++d0) {
      const float z = bf2f(epi.z0[zo + cr * LD + d0 * 32]);
      epi.ao0[oo + cr * DM + d0 * 32] = f2bf(o[d0][r] * rs * sgk[d0 * 32] * silu_f(z)); } }
}
constexpr size_t AV_OFF = 0, AK_OFF = 49152, AW_OFF = 81920;
template <int LD, class Epi>
__device__ __forceinline__ void attn_gqa_body(const bf16_t* __restrict__ Qb, const bf16_t* __restrict__ Kh, const bf16_t* __restrict__ Vh,
                                              int seq, char* lds, const float nbC, const Epi& epi, const int wv, const float* qg, const int t0, const float* inv64) {
  constexpr float C = SCALE * 1.4426950408889634f;
  const int lane = fresh_lane(), r32 = lane & 31, hi = lane >> 5;
  char* V_lds = lds + AV_OFF; char* K_lds = lds + AK_OFF;
  float* li_l = (float*)(lds + AW_OFF) + wv * 64;
  f32x16 o[4] = {}; bf16x8 qr[8]; float lsum = 0.f;
  const int vb0 = (int)(uintptr_t)V_lds + v_rd_base(lane);
  const int kb0 = (int)(uintptr_t)K_lds;
  const unsigned kof8 = (unsigned)((8 * wv + (lane >> 3)) * (LD * 2) + (((lane & 7) ^ ((lane >> 3) & 7)) * 16));
  const int keyv = wv * 8 + ((lane & 31) >> 2);
  const unsigned vof = (unsigned)(keyv * LD + (lane >> 5) * 32 + (lane & 3) * 8) * 2u;
  LAS unsigned char* ldl = (LAS unsigned char*)lds;
#define DMA16(gp, lo) __builtin_amdgcn_global_load_lds((const unsigned*)(gp), (LAS unsigned*)(ldl + (lo)), 16, 0, 0)
#define DMA_TILE(t, kb, vo) do { const char* kg_ = (const char*)Kh + (size_t)(t) * (KVBLK * LD * 2); const char* vg_ = (const char*)Vh + (size_t)(t) * (KVBLK * LD * 2); \
    DMA16(kg_ + kof8, AK_OFF + (kb) * 16384 + wv * 1024);                                                                                   \
    DMA16(vg_ + vof, AV_OFF + (vo) + wv * 2048); DMA16(vg_ + vof + 128, AV_OFF + (vo) + wv * 2048 + 1024); } while (0)
#define WBAR(n) do { asm volatile("s_waitcnt vmcnt(" #n ") lgkmcnt(0)" ::: "memory"); __builtin_amdgcn_s_barrier(); asm volatile("" ::: "memory"); } while (0)
#define PK4(P, BASE, OUT) do { u32x4 w = {cvtpk2(P[BASE + 0], P[BASE + 1]), cvtpk2(P[BASE + 2], P[BASE + 3]), cvtpk2(P[BASE + 4], P[BASE + 5]), cvtpk2(P[BASE + 6], P[BASE + 7])}; \
    OUT = *reinterpret_cast<bf16x8*>(&w); } while (0)
#define EXPC(P, lo) do { _Pragma("unroll") for (int r = (lo); r < (lo) + 8; ++r) { P[r] = __builtin_amdgcn_exp2f(P[r]); lsum += P[r]; } } while (0)
#define PACK() do { PK4(p0, 0, pa0); PK4(p0, 8, pa1); PK4(p1, 0, pa2); PK4(p1, 8, pa3); } while (0)
#ifndef NOINT_A
#define PVX(vo) do { pv_one<0>(o[0], vb0 + (vo), pa0, pa1, pa2, pa3); EXPC(p0, 0); pv_one<1>(o[1], vb0 + (vo), pa0, pa1, pa2, pa3); EXPC(p0, 8);    \
    pv_one<2>(o[2], vb0 + (vo), pa0, pa1, pa2, pa3); EXPC(p1, 0); pv_one<3>(o[3], vb0 + (vo), pa0, pa1, pa2, pa3); EXPC(p1, 8); SBAR(); PACK(); } while (0)
#else
#define PVX(vo) do { pv_d0(o, vb0 + (vo), pa0, pa1, pa2, pa3); EXPC(p0, 0); EXPC(p0, 8); EXPC(p1, 0); EXPC(p1, 8); SBAR(); PACK(); } while (0)
#endif
#define KADDR() int sw_ = (r32 & 7); asm volatile("" : "+v"(sw_)); const int kr_ = kb0 + r32 * 128;                                               \
    const int a0_ = kr_ + (((2 * hi) ^ sw_) << 4), a1_ = kr_ + (((2 * hi + 1) ^ sw_) << 4), a2_ = kr_ + (((4 + 2 * hi) ^ sw_) << 4), a3_ = kr_ + (((5 + 2 * hi) ^ sw_) << 4)
#define KLD(dst, A0, A1, OFF) do { dst.lo = *(const LAS i32x4*)(unsigned)((A0) + (OFF)); dst.hi = *(const LAS i32x4*)(unsigned)((A1) + (OFF)); } while (0)
#define MF8(dst, ka, qv, cin) asm volatile("v_mfma_scale_f32_32x32x64_f8f6f4 %0, %1, %2, %3, %4, %4 op_sel_hi:[0,0,0]" : "=&v"(dst) : "v"(ka), "v"(qv), "v"(cin), "v"(f8one))
#define MF8A(dst, ka, qv) asm volatile("v_mfma_scale_f32_32x32x64_f8f6f4 %0, %1, %2, %0, %3, %3 op_sel_hi:[0,0,0]" : "+v"(dst) : "v"(ka), "v"(qv), "v"(f8one))
#define TRA(T, D0, vb_) do { T[0] = tr_read<v_rd_off(D0, 0, 0)>(vb_); T[1] = tr_read<v_rd_off(D0, 0, 1)>(vb_); T[2] = tr_read<v_rd_off(D0, 1, 0)>(vb_); T[3] = tr_read<v_rd_off(D0, 1, 1)>(vb_); \
    T[4] = tr_read<v_rd_off(D0, 2, 0)>(vb_); T[5] = tr_read<v_rd_off(D0, 2, 1)>(vb_); T[6] = tr_read<v_rd_off(D0, 3, 0)>(vb_); T[7] = tr_read<v_rd_off(D0, 3, 1)>(vb_); } while (0)
#define TRW(T, n) asm volatile("s_waitcnt lgkmcnt(" #n ")" : "+v"(T[0]), "+v"(T[1]), "+v"(T[2]), "+v"(T[3]), "+v"(T[4]), "+v"(T[5]), "+v"(T[6]), "+v"(T[7]) :: "memory")
#define PKV(L, H) (bf16x8){L[0], L[1], L[2], L[3], H[0], H[1], H[2], H[3]}
#define MB(od, T) do { od = __builtin_amdgcn_mfma_f32_32x32x16_bf16(pa0, PKV(T[0], T[1]), od, 0, 0, 0); od = __builtin_amdgcn_mfma_f32_32x32x16_bf16(pa1, PKV(T[2], T[3]), od, 0, 0, 0); \
    od = __builtin_amdgcn_mfma_f32_32x32x16_bf16(pa2, PKV(T[4], T[5]), od, 0, 0, 0); od = __builtin_amdgcn_mfma_f32_32x32x16_bf16(pa3, PKV(T[6], T[7]), od, 0, 0, 0); } while (0)
#define PZ() f32x16 pz_; { float nb_ = nbC; asm volatile("" : "+v"(nb_)); _Pragma("unroll") for (int r = 0; r < 16; ++r) pz_[r] = nb_; }
#define SCORES(KOFF) do { PZ(); i32x8 k0_, k1_, k2_, k3_;                                                                                      \
    KLD(k0_, a0_, a1_, (KOFF)); KLD(k1_, a0_, a1_, (KOFF) + 4096); KLD(k2_, a2_, a3_, (KOFF)); KLD(k3_, a2_, a3_, (KOFF) + 4096);              \
    MF8(p0, k0_, qf[0], pz_); MF8(p1, k1_, qf[0], pz_); MF8A(p0, k2_, qf[1]); MF8A(p1, k3_, qf[1]);                                            \
    asm volatile("s_nop 15\n\ts_nop 15" ::: "memory"); } while (0)
#define STEP(KOFF) do { const int vb_ = vb0 + v0; KADDR(); PZ(); i32x8 k0_, k1_, k2_, k3_;                                                      \
    TRA(trA, 0, vb_);                                                                                                                          \
    KLD(k0_, a0_, a1_, (KOFF)); KLD(k1_, a0_, a1_, (KOFF) + 4096);                                                                              \
    MF8(p0, k0_, qf[0], pz_); MF8(p1, k1_, qf[0], pz_);                                                                                        \
    KLD(k2_, a2_, a3_, (KOFF)); KLD(k3_, a2_, a3_, (KOFF) + 4096);                                                                              \
    TRW(trA, 0); TRA(trB, 1, vb_);                                                                                                             \
    MF8A(p0, k2_, qf[1]); MF8A(p1, k3_, qf[1]);                                                                                                \
    MB(o[0], trA); TRW(trB, 0); TRA(trA, 2, vb_);                                                                                              \
    MB(o[1], trB); asm volatile("s_nop 7" ::: "memory"); EXPC(p0, 0); TRW(trA, 0); TRA(trB, 3, vb_);                                           \
    MB(o[2], trA); EXPC(p0, 8); TRW(trB, 0);                                                                                                   \
    MB(o[3], trB); EXPC(p1, 0); EXPC(p1, 8);                                                                                                   \
    PACK(); } while (0)
  f32x16 p0, p1; bf16x8 pa0, pa1, pa2, pa3; i32x8 qf[2]; s16x4 trA[8], trB[8]; const int NT = seq / KVBLK;
  int f8one = 0x7F7F7F7F; asm volatile("" : "+v"(f8one));
  int v0 = 0, v1 = 16384, v2 = 32768;
  DMA_TILE(0, 0, 0); DMA_TILE(1, 1, 16384);
  { const bf16_t* Qw = Qb + (unsigned)((wv * QBLK + r32) * LD + hi * 8);
    _Pragma("unroll")
    for (int d0 = 0; d0 < 8; ++d0) qr[d0] = ld8(Qw + d0 * 16);
    q_prep<true>(qr, qg, t0 + wv * QBLK + r32, hi, inv64, qf); }
  WBAR(0);
  { KADDR(); SCORES(0); } EXPC(p0, 0); EXPC(p0, 8); EXPC(p1, 0); EXPC(p1, 8); PACK();
  WBAR(0);
  for (int j = 1; j + 1 < NT; j += 2) {
    DMA_TILE(j + 1, 0, v2);
    STEP(16384);
    WBAR(0);
    { const int t = v0; v0 = v1; v1 = v2; v2 = t; }
    DMA_TILE(j + 2, 1, v2);
    STEP(0);
    WBAR(0);
    { const int t = v0; v0 = v1; v1 = v2; v2 = t; }
  }
  STEP(16384);
  { const int vb_ = vb0 + v1;
    TRA(trA, 0, vb_); TRW(trA, 0); TRA(trB, 1, vb_);
    MB(o[0], trA); TRW(trB, 0); TRA(trA, 2, vb_);
    MB(o[1], trB); TRW(trA, 0); TRA(trB, 3, vb_);
    MB(o[2], trA); TRW(trB, 0);
    MB(o[3], trB); }
  WBAR(0);
#undef DMA16
#undef DMA_TILE
#undef WBAR
#undef PK4
#undef EXPC
#undef PACK
#undef PVX
#undef KADDR
#undef KLD
#undef MF8
#undef MF8A
#undef TRA
#undef TRW
#undef PKV
#undef MB
#undef SCORES
#undef STEP
#undef PZ
  { auto rr = __builtin_amdgcn_permlane32_swap(__float_as_uint(lsum), __float_as_uint(lsum), false, false);
    lsum = __uint_as_float(rr[0]) + __uint_as_float(rr[1]); }
  const int lane2 = fresh_lane(), r32e = lane2 & 31, hie = lane2 >> 5;
  if (hie == 0) li_l[r32e] = lsum; asm volatile("s_waitcnt lgkmcnt(0)" ::: "memory");
  float rli[16];
#pragma unroll
  for (int r = 0; r < 16; ++r) rli[r] = __builtin_amdgcn_rcpf(li_l[crow(r, hie)]);
  epi(o, rli, wv, r32e, hie, lane2);
}
}

__device__ const float inv64_tab[64] = {
 1.000000000e+00f, 8.659643234e-01f, 7.498942093e-01f, 6.493816316e-01f, 5.623413252e-01f, 4.869675252e-01f, 4.216965034e-01f, 3.651741273e-01f, 3.162277660e-01f, 2.738419634e-01f, 2.371373706e-01f, 2.053525026e-01f, 1.778279410e-01f, 1.539926526e-01f, 1.333521432e-01f, 1.154781985e-01f,
 1.000000000e-01f, 8.659643234e-02f, 7.498942093e-02f, 6.493816316e-02f, 5.623413252e-02f, 4.869675252e-02f, 4.216965034e-02f, 3.651741273e-02f, 3.162277660e-02f, 2.738419634e-02f, 2.371373706e-02f, 2.053525026e-02f, 1.778279410e-02f, 1.539926526e-02f, 1.333521432e-02f, 1.154781985e-02f,
 1.000000000e-02f, 8.659643234e-03f, 7.498942093e-03f, 6.493816316e-03f, 5.623413252e-03f, 4.869675252e-03f, 4.216965034e-03f, 3.651741273e-03f, 3.162277660e-03f, 2.738419634e-03f, 2.371373706e-03f, 2.053525026e-03f, 1.778279410e-03f, 1.539926526e-03f, 1.333521432e-03f, 1.154781985e-03f,
 1.000000000e-03f, 8.659643234e-04f, 7.498942093e-04f, 6.493816316e-04f, 5.623413252e-04f, 4.869675252e-04f, 4.216965034e-04f, 3.651741273e-04f, 3.162277660e-04f, 2.738419634e-04f, 2.371373706e-04f, 2.053525026e-04f, 1.778279410e-04f, 1.539926526e-04f, 1.333521432e-04f, 1.154781985e-04f};

struct Args { const float* in[17]; float* out; unsigned char* ws; int ph_lo, ph_hi; };

__device__ __forceinline__ unsigned f2bf_sw(float f) { unsigned u = __float_as_uint(f); return (u + 0x7fffu + ((u >> 16) & 1u)) >> 16; }
__device__ __forceinline__ unsigned pk2(float lo, float hi) { return f2bf_sw(lo) | (f2bf_sw(hi) << 16); }

__device__ __forceinline__ void transpose_item(const float* W, int K, int N, bf16_t* WT, LAS float* scr, int item, int lane) {
  const int nblk = N / 32, kb = item / nblk, nb = item % nblk, k0 = 64 * kb, n0 = 32 * nb;
  { f32x4 t[8];
#pragma unroll
    for (int i = 0; i < 8; ++i) t[i] = *(const f32x4*)(W + (size_t)(k0 + 8 * i + (lane >> 3)) * N + n0 + (lane & 7) * 4);
#pragma unroll
    for (int i = 0; i < 8; ++i) { LAS float* d = scr + (8 * i + (lane >> 3)) * 33 + (lane & 7) * 4; d[0] = t[i].x; d[1] = t[i].y; d[2] = t[i].z; d[3] = t[i].w; } }
  LDS_WAIT(); asm volatile("" ::: "memory");
  const int c = lane & 7;
#pragma unroll
  for (int j = 0; j < 4; ++j) { const int n = (lane >> 3) + 8 * j; const LAS float* s = scr + (8 * c) * 33 + n;
    u32x4 o; o.x = pk2(s[0 * 33], s[1 * 33]); o.y = pk2(s[2 * 33], s[3 * 33]); o.z = pk2(s[4 * 33], s[5 * 33]); o.w = pk2(s[6 * 33], s[7 * 33]);
    *(u32x4*)(WT + (size_t)(n0 + n) * K + k0 + 8 * c) = o; }
  LDS_WAIT(); asm volatile("" ::: "memory");
}

__device__ __forceinline__ void transpose_item_f8(const float* W, int K, int N, unsigned char* WT, LAS float* scr, int item, int lane, float scale) {
  const int nblk = N / 32, kb = item / nblk, nb = item % nblk, k0 = 64 * kb, n0 = 32 * nb;
  { f32x4 t[8];
#pragma unroll
    for (int i = 0; i < 8; ++i) t[i] = *(const f32x4*)(W + (size_t)(k0 + 8 * i + (lane >> 3)) * N + n0 + (lane & 7) * 4);
#pragma unroll
    for (int i = 0; i < 8; ++i) { LAS float* d = scr + (8 * i + (lane >> 3)) * 33 + (lane & 7) * 4; d[0] = t[i].x * scale; d[1] = t[i].y * scale; d[2] = t[i].z * scale; d[3] = t[i].w * scale; } }
  LDS_WAIT(); asm volatile("" ::: "memory");
  const int c = lane & 3;
#pragma unroll
  for (int j = 0; j < 2; ++j) { const int n = (lane >> 2) + 16 * j; const LAS float* s = scr + (16 * c) * 33 + n;
    u32x4 o; o.x = pk4_fp8(s[0 * 33], s[1 * 33], s[2 * 33], s[3 * 33]); o.y = pk4_fp8(s[4 * 33], s[5 * 33], s[6 * 33], s[7 * 33]);
    o.z = pk4_fp8(s[8 * 33], s[9 * 33], s[10 * 33], s[11 * 33]); o.w = pk4_fp8(s[12 * 33], s[13 * 33], s[14 * 33], s[15 * 33]);
    *(u32x4*)(WT + (size_t)(n0 + n) * K + k0 + 16 * c) = o; }
  LDS_WAIT(); asm volatile("" ::: "memory");
}

__device__ __forceinline__ void phase_norm(const Args& a, int L, LAS unsigned char* lds, int wave, int lane, int bid) {
  const int isB = L & 1, jj = L >> 1, NIN = isB ? B_IN : A_IN;
  const float* Win = a.in[isB ? 8 : 3] + (size_t)jj * DM * NIN;
  const float* Wout = a.in[isB ? 16 : 6] + (size_t)jj * DM * DM;
  const float* ng = a.in[isB ? 7 : 2] + jj * DM;
  bf16_t* WinT = (bf16_t*)(a.ws + WS_WIN); bf16_t* WoutT = (bf16_t*)(a.ws + WS_WOUT); bf16_t* XN = (bf16_t*)(a.ws + WS_XN);
  LAS float* scr = (LAS float*)(lds + wave * 16384);
  const int gw = bid * 8 + wave, NGW = gridDim.x * 8;
  const int I_in = (DM / 64) * (NIN / 32), I_out = (DM / 64) * (DM / 32);
  for (int it = gw; it < I_in + I_out; it += NGW) {
    if (isB) { if (it < I_in) transpose_item(Win, DM, NIN, WinT, scr, it, lane); else transpose_item(Wout, DM, DM, WoutT, scr, it - I_in, lane); }
    else { if (it < I_in) transpose_item_f8(Win, DM, NIN, (unsigned char*)WinT, scr, it, lane, F8_WSCALE); else transpose_item_f8(Wout, DM, DM, (unsigned char*)WoutT, scr, it - I_in, lane, F8_WSCALE); }
  }
  f32x4 g4[8];
#pragma unroll
  for (int j = 0; j < 8; ++j) g4[j] = ((const f32x4*)ng)[lane + 64 * j];
  for (int m = gw; m < M; m += NGW) {
    const float* xr = (L == 0) ? (m < MP ? a.in[0] + (size_t)m * DM : a.in[1] + (size_t)(m - MP) * DM) : a.out + (size_t)m * DM;
    f32x4 v[8]; float s = 0.f;
#pragma unroll
    for (int j = 0; j < 8; ++j) { v[j] = ((const f32x4*)xr)[lane + 64 * j]; s += (v[j].x * v[j].x + v[j].y * v[j].y) + (v[j].z * v[j].z + v[j].w * v[j].w); }
    const float rs = __builtin_amdgcn_rsqf(wave_sum(s) * (1.f / DM) + EPS);
    if (isB) { u32x2* o8 = (u32x2*)(XN + (size_t)m * DM) + lane;
#pragma unroll
      for (int j = 0; j < 8; ++j) { const f32x4 y = v[j] * rs * g4[j]; u32x2 w; w.x = cvtpk(y.x, y.y); w.y = cvtpk(y.z, y.w); o8[64 * j] = w; } }
    else { unsigned* o4 = (unsigned*)((unsigned char*)XN + (size_t)m * DM) + lane;
#pragma unroll
      for (int j = 0; j < 8; ++j) { const f32x4 y = v[j] * rs * g4[j]; o4[64 * j] = pk4_fp8(y.x, y.y, y.z, y.w); } }
  }
}

__device__ __forceinline__ void phase_qkrope(const Args& a, int L, LAS unsigned char* lds, int wave, int lane, int bid) {
  const int isB = L & 1, jj = L >> 1, NIN = isB ? B_IN : A_IN;
  const int nheads = isB ? 32 : 20;
  const float* qg = a.in[isB ? 9 : 4] + jj * 128; const float* kg = a.in[isB ? 10 : 5] + jj * 128;
  bf16_t* proj = (bf16_t*)(a.ws + WS_PROJ);
  LAS float* tbl = (LAS float*)(lds) + wave * 128;
  const int sub = lane & 15, grp = lane >> 4;
  float gq[8], gk[8];
#pragma unroll
  for (int k = 0; k < 8; ++k) { gq[k] = qg[sub * 8 + k] * (att::SCALE * 1.4426950408889634f); gk[k] = kg[sub * 8 + k]; }
  const int tb = isB ? (sub & 7) * 8 : ((sub >> 3) * 32 + (sub & 3) * 8);
  const int pmask = isB ? 8 : 4;
  const bool second = (sub & pmask) != 0;
  const float invf = isB ? inv64_tab[lane] : inv64_tab[2 * (lane & 31)];
  const int gw = bid * 8 + wave, NGW = gridDim.x * 8;
  for (int m = gw; m < M; m += NGW) {
    const int t = m < MP ? (m & (SEQ_P - 1)) : ((m - MP) & (SEQ_S - 1));
    const float pos = isB ? (float)t : (lane < 32 ? (float)(t >> 6) : (float)(t & 63));
    const float ang = pos * invf;
    tbl[lane] = cosf(ang); tbl[64 + lane] = sinf(ang);
    LDS_WAIT();
    float cs[8], sn[8];
#pragma unroll
    for (int k = 0; k < 8; ++k) { cs[k] = tbl[tb + k]; sn[k] = tbl[64 + tb + k]; }
    bf16_t* prow = proj + (size_t)m * NIN;
    bf16x8 raw[8];
#pragma unroll
    for (int q = 4; q < 8; ++q) if (q * 4 < nheads) raw[q] = *(const bf16x8*)(prow + (q * 4 + grp) * 128 + sub * 8);
#pragma unroll
    for (int q = 4; q < 8; ++q) if (q * 4 < nheads) {
      const int head = q * 4 + grp;
      float x[8]; float ss = 0.f;
#pragma unroll
      for (int k = 0; k < 8; ++k) { x[k] = bf2f((bf16_t)raw[q][k]); ss += x[k] * x[k]; }
      ss += swz_xor<1>(ss); ss += swz_xor<2>(ss); ss += swz_xor<4>(ss); ss += swz_xor<8>(ss);
      const float rs = __builtin_amdgcn_rsqf(ss * (1.f / 128.f) + EPS);
      const bool isq = head < 16;
      float y[8], p[8];
#pragma unroll
      for (int k = 0; k < 8; ++k) y[k] = x[k] * rs * (isq ? gq[k] : gk[k]);
#pragma unroll
      for (int k = 0; k < 8; ++k) p[k] = isB ? swz_xor<8>(y[k]) : swz_xor<4>(y[k]);
#pragma unroll
      for (int k = 0; k < 8; ++k) y[k] = second ? (y[k] * cs[k] + p[k] * sn[k]) : (y[k] * cs[k] - p[k] * sn[k]);
      if (isB) { u32x4 w; w.x = cvtpk(y[0], y[1]); w.y = cvtpk(y[2], y[3]); w.z = cvtpk(y[4], y[5]); w.w = cvtpk(y[6], y[7]);
        *(u32x4*)(prow + head * 128 + sub * 8) = w; }
      else {
        u32x2 w; w.x = pk4_fp8(y[0] * 0.125f, y[1] * 0.125f, y[2] * 0.125f, y[3] * 0.125f); w.y = pk4_fp8(y[4] * 0.125f, y[5] * 0.125f, y[6] * 0.125f, y[7] * 0.125f);
        *(u32x2*)((unsigned char*)(prow + head * 128) + 64 * (sub >> 3) + 32 * (sub & 1) + 8 * ((sub >> 1) & 3)) = w; }
    }
    LDS_WAIT();
  }
}

__device__ __forceinline__ float wave_max(float v) {
  v = fmaxf(v, swz_xor<1>(v)); v = fmaxf(v, swz_xor<2>(v)); v = fmaxf(v, swz_xor<4>(v)); v = fmaxf(v, swz_xor<8>(v)); v = fmaxf(v, swz_xor<16>(v));
  auto rr = __builtin_amdgcn_permlane32_swap(__float_as_uint(v), __float_as_uint(v), false, false);
  return fmaxf(__uint_as_float(rr[0]), __uint_as_float(rr[1]));
}
__device__ __forceinline__ void phase_attn_a(const Args& a, int L, char* lds, int wv, int bid) {
  const bf16_t* proj = (const bf16_t*)(a.ws + WS_PROJ); unsigned char* ao = (unsigned char*)(a.ws + WS_XN);
  float nbC;
  { const int lane = fresh_lane(); const float* qg = a.in[4] + (L >> 1) * 128; const float* kg = a.in[5] + (L >> 1) * 128;
    const float gq = wave_max(fmaxf(fabsf(qg[lane]), fabsf(qg[lane + 64]))), gk = wave_max(fmaxf(fabsf(kg[lane]), fabsf(kg[lane + 64])));
    nbC = -(128.f * gq * gk * 1.02f) * (att::SCALE * 1.4426950408889634f); }
  for (int vw = bid; vw < 256; vw += gridDim.x) {
    const int xcd = vw & 7, w = vw >> 3;
    for (int i = 0; i < 12; ++i) {
      int b, kvh, hl, qb, seq; long seq0;
      if (i < 4) { const int idx = i * 32 + w; b = xcd >> 2; kvh = xcd & 3; hl = idx >> 5; qb = idx & 31; seq = SEQ_S; seq0 = MP + (long)b * SEQ_S; }
      else { const int i2 = i - 4, pair = xcd * 4 + (i2 >> 1), idx = (i2 & 1) * 32 + w; b = pair >> 2; kvh = pair & 3; hl = idx >> 4; qb = idx & 15; seq = SEQ_P; seq0 = (long)b * SEQ_P; }
      const int h = kvh * 4 + hl; const long row0 = seq0 + qb * 256;
      att::EpiA E{proj + row0 * A_IN + 3072 + h * 128, ao + row0 * DM + h * 128};
      att::attn_gqa_body<A_IN, att::EpiA>(proj + row0 * A_IN + h * 128, proj + seq0 * A_IN + 2048 + kvh * 128, proj + seq0 * A_IN + 2560 + kvh * 128, seq, lds, nbC, E, wv, a.in[4] + (L >> 1) * 128, qb * 256, inv64_tab);
    }
  }
}
__device__ __forceinline__ void phase_attn_b(const Args& a, int L, char* lds, int wv, int bid) {
  const int lane = fresh_lane();
  const int jj = L >> 1;
  const bf16_t* proj = (const bf16_t*)(a.ws + WS_PROJ); bf16_t* ao = (bf16_t*)(a.ws + WS_XN);
  const float lam_init = 0.8f - 0.6f * expf(-0.3f * (float)L);
  float d1 = 0.f, d2 = 0.f, gq = 0.f, gk = 0.f;
  { const float* q1 = a.in[11] + jj * 128; const float* k1 = a.in[12] + jj * 128; const float* q2 = a.in[13] + jj * 128; const float* k2 = a.in[14] + jj * 128;
    const float* qg = a.in[9] + jj * 128; const float* kg = a.in[10] + jj * 128;
    d1 = q1[lane] * k1[lane] + q1[lane + 64] * k1[lane + 64]; d2 = q2[lane] * k2[lane] + q2[lane + 64] * k2[lane + 64];
    d1 = wave_sum(d1); d2 = wave_sum(d2);
    gq = wave_max(fmaxf(fabsf(qg[lane]), fabsf(qg[lane + 64]))); gk = wave_max(fmaxf(fabsf(kg[lane]), fabsf(kg[lane + 64]))); }
  const float lam = expf(d1) - expf(d2) + lam_init;
  const float nbC = -(128.f * gq * gk * 1.02f) * (att::SCALE * 1.4426950408889634f);
  const float* sg = a.in[15] + jj * 256;
  unsigned* stash = (unsigned*)(a.ws + WS_STASH + (size_t)bid * 65536);
  for (int vw = bid; vw < 256; vw += gridDim.x) {
    const int xcd = vw & 7, w = vw >> 3;
    for (int i = 0; i < 12; ++i) {
      int b, h, qb, seq; long seq0;
      if (i < 4) { const int pair = xcd * 2 + (i >> 1); b = pair >> 3; h = pair & 7; qb = (i & 1) * 32 + w; seq = SEQ_S; seq0 = MP + (long)b * SEQ_S; }
      else { const int pair = xcd * 8 + (i - 4); b = pair >> 3; h = pair & 7; qb = w; seq = SEQ_P; seq0 = (long)b * SEQ_P; }
      const long row0 = seq0 + qb * 128;
      for (int c = 0; c < 2; ++c) {
        att::EpiD E{c, lam, 1.f - lam_init, proj + row0 * B_IN + 6144 + h * 256, ao + row0 * DM + h * 256, sg, stash};
        att::attn_diff_body<B_IN>(proj + row0 * B_IN + (2 * h + c) * 128, proj + seq0 * B_IN + 2048 + (2 * h + c) * 128,
                                  proj + seq0 * B_IN + 4096 + h * 256, seq, lds, nbC, E, wv, a.in[9] + jj * 128, qb * 128, inv64_tab);
      }
    }
  }
}


__device__ __forceinline__ void grid_bar(unsigned* cnt, unsigned target) {
  asm volatile("s_waitcnt vmcnt(0) lgkmcnt(0)" ::: "memory");
  __syncthreads();
  if (threadIdx.x == 0) {
    __builtin_amdgcn_fence(__ATOMIC_RELEASE, "agent");
    asm volatile("s_waitcnt vmcnt(0)" ::: "memory");
    __hip_atomic_fetch_add(cnt, 1u, __ATOMIC_RELAXED, __HIP_MEMORY_SCOPE_AGENT);
    unsigned spins = 0;
    while (__hip_atomic_load(cnt, __ATOMIC_RELAXED, __HIP_MEMORY_SCOPE_AGENT) < target) { __builtin_amdgcn_s_sleep(2); if (++spins > (1u << 24)) break; }
    __builtin_amdgcn_fence(__ATOMIC_ACQUIRE, "agent");
    asm volatile("s_waitcnt vmcnt(0)" ::: "memory");
  }
  __syncthreads();
}

__global__ void __launch_bounds__(512) fwd_megakernel(Args a) {
  extern __shared__ __attribute__((aligned(16))) unsigned char lds[];
  cg::grid_group grid = cg::this_grid();
  LAS unsigned char* ldsl = (LAS unsigned char*)lds;
  const int wave0 = __builtin_amdgcn_readfirstlane(threadIdx.x >> 6);
  int dup_done = 0; (void)dup_done;
  for (int ph = a.ph_lo; ph < a.ph_hi; ++ph) {
    int bid = blockIdx.x; asm volatile("" : "+s"(bid));
    int wave = wave0; asm volatile("" : "+s"(wave));
    const int L = ph / 5, s = ph - 5 * L, isB = L & 1, NIN = isB ? B_IN : A_IN;
#ifndef PHM
#define PHM 63
#endif
    if (s == 0) { if (PHM & 1) phase_norm(a, L, ldsl, wave, fresh_lane(), bid); }
    else if (s == 1) { if (PHM & 2) {
      pg8::Gemm g{(const bf16_t*)(a.ws + WS_XN), (const bf16_t*)(a.ws + WS_WIN), M, NIN, DM}; pg8::StaticOrder S; S.init(M, NIN, (int)gridDim.x, bid);
      if (isB) { pg8::EpiBf16 E{(bf16_t*)(a.ws + WS_PROJ), NIN, 1.f};
        pg8::gemm_phase<pg8::EpiBf16, pg8::StaticOrder, true, true, false>(ldsl, g, S, E, wave * 64 + fresh_lane()); }
      else { g.K = DM / 2; pg8::EpiBf16 E{(bf16_t*)(a.ws + WS_PROJ), NIN, 1.f / F8_WSCALE};
        pg8::gemm_phase<pg8::EpiBf16, pg8::StaticOrder, true, true, true>(ldsl, g, S, E, wave * 64 + fresh_lane()); }
    } }
    else if (s == 2) { if (PHM & 4) phase_qkrope(a, L, ldsl, wave, fresh_lane(), bid); }
    else if (s == 3) { if (isB) { if (PHM & 8) phase_attn_b(a, L, (char*)lds, wave, bid); } else { if (PHM & 32) phase_attn_a(a, L, (char*)lds, wave, bid); } }
    else if (PHM & 16) {
      pg8::Gemm g{(const bf16_t*)(a.ws + WS_XN), (const bf16_t*)(a.ws + WS_WOUT), M, DM, DM}; pg8::StaticOrder S; S.init(M, DM, (int)gridDim.x, bid);
      pg8::EpiResid E{L == 0 ? a.in[0] : a.out, L == 0 ? a.in[1] : a.out + (size_t)MP * DM, a.out, isB ? 1.f : 1.f / (F8_WSCALE * F8_ASCALE)};
      if (isB) pg8::gemm_phase<pg8::EpiResid, pg8::StaticOrder, true, true, false>(ldsl, g, S, E, wave * 64 + fresh_lane());
      else { g.K = DM / 2; pg8::gemm_phase<pg8::EpiResid, pg8::StaticOrder, true, true, true>(ldsl, g, S, E, wave * 64 + fresh_lane()); }
    }
#ifdef DUP_MASK
    if (!dup_done && (((DUP_MASK) & 1 && s == 0) || ((DUP_MASK) & 2 && s == 1) || ((DUP_MASK) & 8 && s == 3 && isB) || ((DUP_MASK) & 32 && s == 3 && !isB) || ((DUP_MASK) & 64 && s == 4 && L == 0))) { dup_done = 1; --ph; grid.sync(); continue; }
    dup_done = 0;
#endif
    if (ph + 1 < a.ph_hi) {
      if (ph == a.ph_lo) { if (blockIdx.x == 0 && threadIdx.x == 0) __hip_atomic_store((unsigned*)(a.ws + WS_CTL), 0u, __ATOMIC_RELAXED, __HIP_MEMORY_SCOPE_AGENT);
        grid.sync(); }
#ifdef USE_CG_SYNC
      else grid.sync();
#else
      else grid_bar((unsigned*)(a.ws + WS_CTL), (unsigned)(ph - a.ph_lo) * gridDim.x);
#endif
    }
  }
}

extern "C" void kernel_launch(void* const* d_in, const int* in_sizes, int n_in, void* d_out, int out_size, void* d_ws, size_t ws_size, hipStream_t stream) {
  static int grid = 0;
  if (grid == 0) {
    if (n_in != 17 || out_size != M * DM || ws_size < WS_END) { fprintf(stderr, "kernel_launch: unexpected shapes (n_in %d out %d ws %zu)\n", n_in, out_size, ws_size); grid = -1; return; }
    if (hipFuncSetAttribute((const void*)fwd_megakernel, hipFuncAttributeMaxDynamicSharedMemorySize, LDS_BYTES) != hipSuccess) { fprintf(stderr, "kernel_launch: hipFuncSetAttribute failed\n"); grid = -1; return; }
    int dev = 0, cus = 0, per_cu = 0;
    hipGetDevice(&dev); hipDeviceGetAttribute(&cus, hipDeviceAttributeMultiprocessorCount, dev);
    if (hipOccupancyMaxActiveBlocksPerMultiprocessor(&per_cu, (const void*)fwd_megakernel, 512, LDS_BYTES) != hipSuccess || per_cu < 1) { fprintf(stderr, "kernel_launch: occupancy query failed (%d)\n", per_cu); per_cu = 1; }
    (void)hipGetLastError();
    grid = cus * 1;
    if (grid > cus * per_cu) grid = cus * per_cu;
  }
  if (grid < 0) return;
  Args a{};
  for (int i = 0; i < 17; ++i) a.in[i] = (const float*)d_in[i];
  a.out = (float*)d_out; a.ws = (unsigned char*)d_ws;
#if MK_N_LAUNCHES == 1
  a.ph_lo = 0; a.ph_hi = NPHASE;
  void* args[] = {&a};
  hipError_t e = hipLaunchCooperativeKernel((const void*)fwd_megakernel, dim3(grid), dim3(512), args, LDS_BYTES, stream);
  if (e != hipSuccess) fprintf(stderr, "kernel_launch: cooperative launch failed: %s (grid %d)\n", hipGetErrorString(e), grid);
#else
  for (int ph = 0; ph < NPHASE; ++ph) {
    a.ph_lo = ph; a.ph_hi = ph + 1;
    hipLaunchKernelGGL(fwd_megakernel, dim3(grid), dim3(512), LDS_BYTES, stream, a);
  }
#endif
}
```

```cpp
#include <hip/hip_runtime.h>
#include <hip/hip_cooperative_groups.h>
#include <cstdio>
#include <cstdint>
namespace cg = cooperative_groups;

#ifndef MK_N_LAUNCHES
#define MK_N_LAUNCHES 1
#endif

constexpr int DM = 2048, MP = 32768, MS = 16384, M = MP + MS, SEQ_P = 4096, SEQ_S = 8192;
constexpr int A_IN = 5120, B_IN = 8192, NPHASE = 20;
constexpr float EPS = 1e-6f;
constexpr size_t MiB = 1u << 20;
constexpr size_t WS_WIN = 0, WS_WOUT = 32 * MiB, WS_XN = 40 * MiB, WS_PROJ = 232 * MiB, WS_STASH = 1000 * MiB, WS_CTL = 1016 * MiB, WS_END = 1016 * MiB + 4096;
constexpr int LDS_BYTES = 163840;

#define LAS __attribute__((address_space(3)))
typedef unsigned short bf16_t;
typedef short bf16x8 __attribute__((ext_vector_type(8)));
typedef short s16x4 __attribute__((ext_vector_type(4)));
typedef float f32x4 __attribute__((ext_vector_type(4)));
typedef float f32x16 __attribute__((ext_vector_type(16)));
typedef unsigned u32x4 __attribute__((ext_vector_type(4)));
typedef unsigned u32x2 __attribute__((ext_vector_type(2)));

__device__ __forceinline__ unsigned cvtpk(float lo, float hi) { unsigned r; asm volatile("v_cvt_pk_bf16_f32 %0, %1, %2" : "=v"(r) : "v"(lo), "v"(hi)); return r; }
typedef int i32x8 __attribute__((ext_vector_type(8)));
typedef int i32x4 __attribute__((ext_vector_type(4)));
__device__ __forceinline__ unsigned pk4_fp8(float a, float b, float c, float d) { int p = __builtin_amdgcn_cvt_pk_fp8_f32(a, b, 0, false); return (unsigned)__builtin_amdgcn_cvt_pk_fp8_f32(c, d, p, true); }
constexpr float F8_WSCALE = 64.f, F8_ASCALE = 64.f;
typedef __bf16 bf16v2 __attribute__((ext_vector_type(2)));
typedef float f32x2 __attribute__((ext_vector_type(2)));
__device__ __forceinline__ unsigned cvtpk2(float lo, float hi) { return __builtin_bit_cast(unsigned, __builtin_convertvector((f32x2){lo, hi}, bf16v2)); }
__device__ __forceinline__ float bf2f(bf16_t b) { return __uint_as_float((unsigned)b << 16); }
__device__ __forceinline__ bf16_t f2bf(float f) { return (bf16_t)(cvtpk(f, 0.f) & 0xffffu); }
__device__ __forceinline__ float silu_f(float z) { return z * __builtin_amdgcn_rcpf(1.f + __builtin_amdgcn_exp2f(-1.4426950408889634f * z)); }
#define LDS_WAIT() asm volatile("s_waitcnt lgkmcnt(0)" ::: "memory")
__device__ __forceinline__ int fresh_lane() { int l; asm volatile("v_mbcnt_lo_u32_b32 %0, -1, 0\n\tv_mbcnt_hi_u32_b32 %0, -1, %0" : "=v"(l)); return l; }
template <int X> __device__ __forceinline__ float swz_xor(float v) { return __int_as_float(__builtin_amdgcn_ds_swizzle(__float_as_int(v), (X << 10) | 0x1f)); }
__device__ __forceinline__ float wave_sum(float v) {
  v += swz_xor<1>(v); v += swz_xor<2>(v); v += swz_xor<4>(v); v += swz_xor<8>(v); v += swz_xor<16>(v);
  auto rr = __builtin_amdgcn_permlane32_swap(__float_as_uint(v), __float_as_uint(v), false, false);
  return __uint_as_float(rr[0]) + __uint_as_float(rr[1]);
}

namespace pg8 {
#define PG8_LAS __attribute__((address_space(3)))
constexpr int BM = 256, BK = 64, HALF = 128, HTB = HALF * BK * 2, STAGE_BYTES = 8 * HTB, NXCD = 8, WGM = 8;
__host__ __device__ __forceinline__ int lds_byte(int r, int c) { const int st = (r >> 4) * 2 + (c >> 5), rr = r & 15, cc = c & 31, ob = rr * 64 + cc * 2; return st * 1024 + (ob ^ (((ob >> 9) & 1) << 5)); }
__host__ __device__ __forceinline__ void stage_rc(int b, int& R, int& C) { const int st = b / 1024, sb = b % 1024, swz = sb ^ (((sb >> 9) & 1) << 5); R = (st >> 1) * 16 + swz / 64; C = (st & 1) * 32 + (swz % 64) / 2; }
__host__ __device__ __forceinline__ int perm32(int rho) { const int n = rho >> 4, i = rho & 15; return 8 * (i >> 2) + 4 * n + (i & 3); }
struct Unit { int pm, pn; };
struct Gemm { const bf16_t* A; const bf16_t* Bt; int M, N, K; };
struct StaticOrder {
    int nM, nN, nwg, G, c;
    __host__ __device__ void init(int M_, int N_, int G_, int c_) { nM = M_ / BM; nN = N_ / BM; nwg = nM * nN; G = G_; c = c_; }
    __host__ __device__ bool next(int i, Unit& u) const {
        const long L = (long)i * G + c; if (L >= nwg) return false;
        int wgid = (int)L; { const int q = nwg / NXCD, r = nwg % NXCD, xcd = wgid % NXCD, off = wgid / NXCD; wgid = (xcd < r ? xcd * (q + 1) : r * (q + 1) + (xcd - r) * q) + off; }
        const int nig = WGM * nN, gid = wgid / nig, fm = gid * WGM, gsz = (nM - fm) < WGM ? (nM - fm) : WGM;
        u.pm = fm + ((wgid % nig) % gsz); u.pn = (wgid % nig) / gsz; return true;
    }
    __device__ __forceinline__ void a_ready(const Unit&) const {}
    __device__ __forceinline__ void done(const Unit&) const {}
};
struct EpiBf16 {
    static constexpr bool PERM = true, AFTER_DRAIN = false;
    bf16_t* O; int ldc; float scale;
    __device__ __forceinline__ void operator()(const f32x4 (&acc)[2][2][4][2], const Unit& u, int wr, int wc, int fr, int fq) const {
        const int row0 = u.pm * BM + wr * 64 + fr; const int col0 = u.pn * BM + wc * 32 + 8 * fq;
#pragma unroll
        for (int ai = 0; ai < 2; ++ai)
#pragma unroll
            for (int m = 0; m < 4; ++m) { bf16_t* rowp = O + (size_t)(row0 + ai * HALF + m * 16) * ldc + col0;
#pragma unroll
                for (int bj = 0; bj < 2; ++bj) { const f32x4 v0 = acc[ai][bj][m][0] * scale, v1 = acc[ai][bj][m][1] * scale;
                    u32x4 w; w.x = cvtpk(v0[0], v0[1]); w.y = cvtpk(v0[2], v0[3]); w.z = cvtpk(v1[0], v1[1]); w.w = cvtpk(v1[2], v1[3]);
                    *(u32x4*)(rowp + bj * HALF) = w; } }
    }
};
struct EpiResid {
    static constexpr bool PERM = false, AFTER_DRAIN = false;
    const float* baseP; const float* baseS; float* out; float scale;
    __device__ __forceinline__ void operator()(const f32x4 (&acc)[2][2][4][2], const Unit& u, int wr, int wc, int fr, int fq) const {
        const int rowt = u.pm * BM;
        const float* base = (rowt < MP ? baseP + (size_t)rowt * DM : baseS + (size_t)(rowt - MP) * DM) + u.pn * BM;
        float* o = out + (size_t)rowt * DM + u.pn * BM;
        unsigned lo = (unsigned)((wr * 64 + fr) * DM + wc * 32 + 4 * fq); asm volatile("" : "+v"(lo));
#pragma unroll
        for (int ai = 0; ai < 2; ++ai)
#pragma unroll
            for (int m = 0; m < 4; ++m) { const unsigned off = lo + (unsigned)((ai * HALF + m * 16) * DM);
#pragma unroll
                for (int bj = 0; bj < 2; ++bj) {
                    const f32x4 b0 = *(const f32x4*)(base + off + bj * HALF), b1 = *(const f32x4*)(base + off + bj * HALF + 16);
                    *(f32x4*)(o + off + bj * HALF) = b0 + acc[ai][bj][m][0] * scale; *(f32x4*)(o + off + bj * HALF + 16) = b1 + acc[ai][bj][m][1] * scale; }
                asm volatile("" ::: "memory"); }
    }
};

template <class Epi, class Sched, bool ALIGN_EPI = false, bool SP2 = false, bool F8 = false>
__device__ __forceinline__ void gemm_phase(PG8_LAS unsigned char* lds, const Gemm g, const Sched& S, const Epi& E, const int tid) {
    const int wid = __builtin_amdgcn_readfirstlane(tid >> 6), lane = tid & 63, wr = wid >> 2, wc = wid & 3, fr = lane & 15, fq = lane >> 4;
    const int K = g.K, nt = K / BK;
    unsigned voffA[2], voffB[2];
#pragma unroll
    for (int i = 0; i < 2; ++i) { int R, C; stage_rc(tid * 16 + i * 8192, R, C); const int Rb = Epi::PERM ? ((R & ~31) + perm32(R & 31)) : R;
        voffA[i] = (unsigned)(R * K + C) * 2u; voffB[i] = (unsigned)(Rb * K + C) * 2u; }
    const size_t kstep = (size_t)(BK * 2);
    const size_t hstep = (size_t)HALF * K * 2;
    const size_t tstep = 2 * hstep;
    const unsigned ldsw = (unsigned)wid * 1024u;
    const int aoff = lds_byte(wr * 64 + fr, fq * 8), boff = lds_byte(wc * 32 + fr, fq * 8);
#define PG8_SA(b, h) (((b) * 2 + (h)) * HTB)
#define PG8_SB(b, h) ((4 + (b) * 2 + (h)) * HTB)
#define PG8_STAGE(bufoff, gbase, voff) do { _Pragma("unroll") for (int _i = 0; _i < 2; ++_i) \
        __builtin_amdgcn_global_load_lds((const unsigned*)((const char*)(gbase) + (voff)[_i]), (PG8_LAS unsigned*)(lds + (bufoff) + ldsw + _i * 8192), 16, 0, 0); } while (0)
#define PG8_LDA(dst, b, h) do { _Pragma("unroll") for (int m = 0; m < 4; ++m) { if constexpr (F8) { dst##8[m].lo = *(const PG8_LAS i32x4*)(lds + PG8_SA(b, h) + aoff + m * 2048); dst##8[m].hi = *(const PG8_LAS i32x4*)(lds + PG8_SA(b, h) + aoff + m * 2048 + 1024); } \
        else { _Pragma("unroll") for (int k = 0; k < 2; ++k) dst[m][k] = *(const PG8_LAS bf16x8*)(lds + PG8_SA(b, h) + aoff + m * 2048 + k * 1024); } } } while (0)
#define PG8_LDB(dst, b, h) do { _Pragma("unroll") for (int n = 0; n < 2; ++n) { if constexpr (F8) { dst##8[n].lo = *(const PG8_LAS i32x4*)(lds + PG8_SB(b, h) + boff + n * 2048); dst##8[n].hi = *(const PG8_LAS i32x4*)(lds + PG8_SB(b, h) + boff + n * 2048 + 1024); } \
        else { _Pragma("unroll") for (int k = 0; k < 2; ++k) dst[n][k] = *(const PG8_LAS bf16x8*)(lds + PG8_SB(b, h) + boff + n * 2048 + k * 1024); } } } while (0)
#define PG8_MMA(ai, bj, At, Bt) do { __builtin_amdgcn_s_setprio(1); _Pragma("unroll") for (int m = 0; m < 4; ++m) _Pragma("unroll") for (int n = 0; n < 2; ++n) {                          \
        if constexpr (F8) asm volatile("v_mfma_scale_f32_16x16x128_f8f6f4 %0, %1, %2, %0, %3, %3 op_sel_hi:[0,0,0]" : "+v"(acc[ai][bj][m][n]) : "v"(Bt##8[n]), "v"(At##8[m]), "v"(f8one));    \
        else { _Pragma("unroll") for (int k = 0; k < 2; ++k) acc[ai][bj][m][n] = __builtin_amdgcn_mfma_f32_16x16x32_bf16(Bt[n][k], At[m][k], acc[ai][bj][m][n], 0, 0, 0); } }        \
        __builtin_amdgcn_s_setprio(0); } while (0)
#define PG8_WAIT_V(n) asm volatile("s_waitcnt vmcnt(" #n ")" ::: "memory")
#define PG8_WAIT_L(n) asm volatile("s_waitcnt lgkmcnt(" #n ")" ::: "memory")
#define PG8_BAR __builtin_amdgcn_s_barrier()
#define PG8_SCHED __builtin_amdgcn_sched_barrier(0)
    Unit cur, nxt; int ui = 0;
    if (!S.next(0, cur)) return;
    f32x4 acc[2][2][4][2];
#pragma unroll
    for (int a = 0; a < 2; ++a)
#pragma unroll
        for (int b = 0; b < 2; ++b)
#pragma unroll
            for (int m = 0; m < 4; ++m)
#pragma unroll
                for (int n = 0; n < 2; ++n) acc[a][b][m][n] = (f32x4){0.f, 0.f, 0.f, 0.f};
    int f8one = 0x7F7F7F7F; asm volatile("" : "+v"(f8one));
    bf16x8 At[4][2], B0[2][2], B1[2][2]; i32x8 At8[4], B08[2], B18[2];
    const char* cA = (const char*)g.A + (size_t)cur.pm * tstep; const char* cB = (const char*)g.Bt + (size_t)cur.pn * tstep;
    S.a_ready(cur);
    if constexpr (SP2) {
        PG8_STAGE(PG8_SB(0, 0), cB, voffB); PG8_STAGE(PG8_SB(0, 1), cB + hstep, voffB); PG8_STAGE(PG8_SA(0, 0), cA, voffA); PG8_STAGE(PG8_SA(0, 1), cA + hstep, voffA);
        if (wr == 1) PG8_BAR;
        PG8_WAIT_V(2); PG8_BAR;
        PG8_STAGE(PG8_SB(1, 0), cB + kstep, voffB); PG8_STAGE(PG8_SA(1, 0), cA + kstep, voffA); PG8_STAGE(PG8_SB(1, 1), cB + hstep + kstep, voffB);
        PG8_WAIT_V(6); PG8_BAR;
    } else {
        PG8_STAGE(PG8_SB(0, 0), cB, voffB); PG8_STAGE(PG8_SA(0, 0), cA, voffA); PG8_STAGE(PG8_SB(0, 1), cB + hstep, voffB); PG8_STAGE(PG8_SA(0, 1), cA + hstep, voffA);
        if (wr == 1) PG8_BAR;
        PG8_WAIT_V(4); PG8_BAR;
        PG8_STAGE(PG8_SB(1, 0), cB + kstep, voffB); PG8_STAGE(PG8_SA(1, 0), cA + kstep, voffA); PG8_STAGE(PG8_SB(1, 1), cB + hstep + kstep, voffB);
        PG8_WAIT_V(6); PG8_BAR;
    }
    for (;;) {
        const bool has_next = S.next(ui + 1, nxt);
        const char* nA = has_next ? (const char*)g.A + (size_t)nxt.pm * tstep : cA; const char* nB = has_next ? (const char*)g.Bt + (size_t)nxt.pn * tstep : cB;
        for (int t = 0; t < nt; t += 2) {
            const bool last = (t == nt - 2);
            const char* a1 = cA + (size_t)(t + 1) * kstep;
            const char* a2 = last ? nA : cA + (size_t)(t + 2) * kstep; const char* b2 = last ? nB : cB + (size_t)(t + 2) * kstep;
            const char* a3 = a2 + kstep; const char* b3 = b2 + kstep;
            if (last && has_next) S.a_ready(nxt);
            if constexpr (SP2) {
            PG8_LDB(B0, 0, 0); PG8_LDB(B1, 0, 1); PG8_SCHED; PG8_LDA(At, 0, 0); PG8_STAGE(PG8_SA(1, 1), a1 + hstep, voffA);
            PG8_WAIT_V(8); PG8_WAIT_L(0); PG8_BAR; PG8_MMA(0, 0, At, B0); PG8_MMA(0, 1, At, B1); PG8_BAR; PG8_SCHED;
            PG8_LDA(At, 0, 1); PG8_STAGE(PG8_SB(0, 0), b2, voffB); PG8_STAGE(PG8_SB(0, 1), b2 + hstep, voffB); PG8_STAGE(PG8_SA(0, 0), a2, voffA);
            PG8_WAIT_V(8); PG8_WAIT_L(0); PG8_BAR; PG8_MMA(1, 0, At, B0); PG8_MMA(1, 1, At, B1); PG8_BAR; PG8_SCHED;
            PG8_LDB(B0, 1, 0); PG8_LDB(B1, 1, 1); PG8_SCHED; PG8_LDA(At, 1, 0); PG8_STAGE(PG8_SA(0, 1), a2 + hstep, voffA);
            PG8_WAIT_V(8); PG8_WAIT_L(0); PG8_BAR; PG8_MMA(0, 0, At, B0); PG8_MMA(0, 1, At, B1); PG8_BAR; PG8_SCHED;
            PG8_LDA(At, 1, 1); PG8_STAGE(PG8_SB(1, 0), b3, voffB); PG8_STAGE(PG8_SB(1, 1), b3 + hstep, voffB); PG8_STAGE(PG8_SA(1, 0), a3, voffA);
            PG8_WAIT_V(8); PG8_WAIT_L(0); PG8_BAR; PG8_MMA(1, 0, At, B0); PG8_MMA(1, 1, At, B1); PG8_BAR; PG8_SCHED;
            } else {
            PG8_LDB(B0, 0, 0); PG8_SCHED; PG8_LDA(At, 0, 0); PG8_STAGE(PG8_SA(1, 1), a1 + hstep, voffA);
            PG8_WAIT_L(8); PG8_BAR; PG8_WAIT_L(0); PG8_MMA(0, 0, At, B0); PG8_BAR; PG8_SCHED;
            PG8_LDB(B1, 0, 1); PG8_STAGE(PG8_SB(0, 0), b2, voffB);
            PG8_BAR; PG8_WAIT_L(0); PG8_MMA(0, 1, At, B1); PG8_BAR;
            PG8_LDA(At, 0, 1); PG8_STAGE(PG8_SA(0, 0), a2, voffA);
            PG8_BAR; PG8_WAIT_L(0); PG8_MMA(1, 0, At, B0); PG8_BAR; PG8_SCHED;
            PG8_STAGE(PG8_SB(0, 1), b2 + hstep, voffB);
            PG8_WAIT_V(6); PG8_BAR; PG8_MMA(1, 1, At, B1); PG8_BAR;
            PG8_LDB(B0, 1, 0); PG8_SCHED; PG8_LDA(At, 1, 0); PG8_STAGE(PG8_SA(0, 1), a2 + hstep, voffA);
            PG8_WAIT_L(8); PG8_BAR; PG8_WAIT_L(0); PG8_MMA(0, 0, At, B0); PG8_BAR; PG8_SCHED;
            PG8_LDB(B1, 1, 1); PG8_STAGE(PG8_SB(1, 0), b3, voffB);
            PG8_BAR; PG8_WAIT_L(0); PG8_MMA(0, 1, At, B1); PG8_BAR;
            PG8_LDA(At, 1, 1); PG8_STAGE(PG8_SA(1, 0), a3, voffA);
            PG8_BAR; PG8_WAIT_L(0); PG8_MMA(1, 0, At, B0); PG8_BAR; PG8_SCHED;
            PG8_STAGE(PG8_SB(1, 1), b3 + hstep, voffB);
            PG8_WAIT_V(6); PG8_BAR; PG8_MMA(1, 1, At, B1); PG8_BAR;
            }
        }
        if constexpr (ALIGN_EPI) { if (wr == 0) PG8_BAR; }
        if constexpr (F8) asm volatile("s_nop 15\n\ts_nop 15" ::: "memory");
        if constexpr (!Epi::AFTER_DRAIN) { E(acc, cur, wr, wc, fr, fq); S.done(cur); }
        if (!has_next) break;
#pragma unroll
        for (int a = 0; a < 2; ++a)
#pragma unroll
            for (int b = 0; b < 2; ++b)
#pragma unroll
                for (int m = 0; m < 4; ++m)
#pragma unroll
                    for (int n = 0; n < 2; ++n) acc[a][b][m][n] = (f32x4){0.f, 0.f, 0.f, 0.f};
        cur = nxt; cA = nA; cB = nB; ++ui;
        if constexpr (ALIGN_EPI) { if (wr == 1) PG8_BAR; }
    }
    PG8_WAIT_V(0);
    if constexpr (!ALIGN_EPI) { if (wr == 0) PG8_BAR; }
    PG8_BAR;
#undef PG8_SA
#undef PG8_SB
#undef PG8_STAGE
#undef PG8_LDA
#undef PG8_LDB
#undef PG8_MMA
#undef PG8_WAIT_V
#undef PG8_WAIT_L
#undef PG8_BAR
#undef PG8_SCHED
}
}

namespace att {
constexpr int D = 128, NW = 8, QBLK = 32, KVBLK = 64;
constexpr float SCALE = 0.088388347648318440f;
constexpr float THR = 8.f;
constexpr size_t SHM_V = KVBLK * D * 2, SHM_K = KVBLK * D * 2, SHM_ATTN = 2 * SHM_V + 2 * SHM_K + NW * 64 * 4;
constexpr size_t STASH_OFF = SHM_ATTN, STASH_BYTES = 65536, SSQ_OFF = STASH_OFF + STASH_BYTES;
#define KSWZ(row, colB) ((row) * 256 + ((colB) ^ (((row) & 7) << 4)))
#define SBAR() __builtin_amdgcn_sched_barrier(0)
__device__ __forceinline__ int crow(int r, int hi) { return (r & 3) + 8 * (r >> 2) + 4 * hi; }
__device__ __forceinline__ bf16x8 ld8(const bf16_t* p) { return *reinterpret_cast<const bf16x8*>(p); }

__device__ __forceinline__ void partialSM(f32x16& p0, f32x16& p1, float& m_reg, float& mn, float& alpha) {
  constexpr float C = SCALE * 1.4426950408889634f;
  float pmax = p0[0]; for (int r = 1; r < 16; ++r) pmax = fmaxf(pmax, p0[r]); for (int r = 0; r < 16; ++r) pmax = fmaxf(pmax, p1[r]);
  { auto rr = __builtin_amdgcn_permlane32_swap(__float_as_uint(pmax), __float_as_uint(pmax), false, false);
    pmax = fmaxf(__uint_as_float(rr[0]), __uint_as_float(rr[1])); }
  if (__builtin_expect(__all(pmax - m_reg <= THR / SCALE), 1)) { mn = m_reg; alpha = 1.f; }
  else { mn = fmaxf(m_reg, pmax); alpha = __builtin_amdgcn_exp2f((m_reg - mn) * C); m_reg = mn; }
  float mnC = -mn * C;
  for (int r = 0; r < 16; ++r) p0[r] = fmaf(p0[r], C, mnC); for (int r = 0; r < 16; ++r) p1[r] = fmaf(p1[r], C, mnC);
  for (int r = 0; r < 16; ++r) p0[r] = __builtin_amdgcn_exp2f(p0[r]);
}
__device__ __forceinline__ void finishSM(f32x16& p0, f32x16& p1, float alpha, float& l_reg, bf16x8& pa0, bf16x8& pa1, bf16x8& pa2, bf16x8& pa3) {
  for (int r = 0; r < 16; ++r) p1[r] = __builtin_amdgcn_exp2f(p1[r]);
  float ps = 0; for (int r = 0; r < 16; ++r) ps += p0[r]; for (int r = 0; r < 16; ++r) ps += p1[r];
  { auto rr = __builtin_amdgcn_permlane32_swap(__float_as_uint(ps), __float_as_uint(ps), false, false);
    ps = __uint_as_float(rr[0]) + __uint_as_float(rr[1]); }
  l_reg = l_reg * alpha + ps;
#define PK4(P, BASE, OUT) do { unsigned a0 = cvtpk(P[BASE + 0], P[BASE + 1]), a1 = cvtpk(P[BASE + 2], P[BASE + 3]);   \
    unsigned b0 = cvtpk(P[BASE + 4], P[BASE + 5]), b1 = cvtpk(P[BASE + 6], P[BASE + 7]);                              \
    auto r0 = __builtin_amdgcn_permlane32_swap(a0, b0, false, false); auto r1 = __builtin_amdgcn_permlane32_swap(a1, b1, false, false); \
    u32x4 w = {r0[0], r1[0], r0[1], r1[1]}; OUT = *reinterpret_cast<bf16x8*>(&w); } while (0)
  PK4(p0, 0, pa0); PK4(p0, 8, pa1); PK4(p1, 0, pa2); PK4(p1, 8, pa3);
#undef PK4
}
__device__ __forceinline__ void qkt(f32x16& p0, f32x16& p1, const bf16_t* Ks, const bf16x8* qr, int r32, int hi) {
  p0 = f32x16{}; p1 = f32x16{};
  for (int d0 = 0; d0 < 8; ++d0) { int cb = (d0 * 16 + hi * 8) * 2;
    bf16x8 b0 = *reinterpret_cast<const bf16x8*>((const char*)Ks + KSWZ(r32, cb));
    bf16x8 b1 = *reinterpret_cast<const bf16x8*>((const char*)Ks + KSWZ(32 + r32, cb));
    p0 = __builtin_amdgcn_mfma_f32_32x32x16_bf16(b0, qr[d0], p0, 0, 0, 0);
    p1 = __builtin_amdgcn_mfma_f32_32x32x16_bf16(b1, qr[d0], p1, 0, 0, 0); }
}
__device__ __forceinline__ void qkt2(f32x16& p0, f32x16& p1, const int kbase, const bf16x8* qr, int r32, int hi, const f32x16& init) {
  int sw = (r32 & 7) << 4; asm volatile("" : "+v"(sw));
  const int rowb = kbase + r32 * 256 + hi * 16;
#pragma unroll
  for (int d = 0; d < 4; ++d) {
    const int a = kbase + r32 * 256 + ((d * 32 + hi * 16) ^ sw); (void)rowb;
    const bf16x8 b00 = *(const LAS bf16x8*)(unsigned)(a), b01 = *(const LAS bf16x8*)(unsigned)(a + 8192);
    const bf16x8 b10 = *(const LAS bf16x8*)(unsigned)(a + 128), b11 = *(const LAS bf16x8*)(unsigned)(a + 128 + 8192);
    p0 = __builtin_amdgcn_mfma_f32_32x32x16_bf16(b00, qr[d], d == 0 ? init : p0, 0, 0, 0);
    p1 = __builtin_amdgcn_mfma_f32_32x32x16_bf16(b01, qr[d], d == 0 ? init : p1, 0, 0, 0);
    p0 = __builtin_amdgcn_mfma_f32_32x32x16_bf16(b10, qr[d + 4], p0, 0, 0, 0);
    p1 = __builtin_amdgcn_mfma_f32_32x32x16_bf16(b11, qr[d + 4], p1, 0, 0, 0); }
}
__device__ __forceinline__ int v_st(int k, int c) { const int kk = (k & ~0xC) | ((k & 4) << 1) | ((k & 8) >> 1); return ((kk >> 3) * 4 + (c >> 5)) * 512 + ((kk & 7) * 32 + (c & 31)) * 2; }
__device__ __forceinline__ int v_rd_base(int lane) { return ((lane & 3) << 3) | (((lane >> 2) & 3) << 6) | (((lane >> 4) & 1) << 5) | (((lane >> 5) & 1) << 8); }
constexpr int v_rd_off(int d0, int ks, int half) { return d0 * 512 + ks * 4096 + half * 2048; }
template <int OFF> __device__ __forceinline__ bf16x8 lds_rd128(int a) {
  bf16x8 r; asm volatile("ds_read_b128 %0, %1 offset:%2" : "=&v"(r) : "v"(a), "i"(OFF) : "memory"); return r;
}
template <int OFF> __device__ __forceinline__ s16x4 tr_read(int vb) {
  s16x4 r; asm volatile("ds_read_b64_tr_b16 %0, %1 offset:%2" : "=&v"(r) : "v"(vb), "i"(OFF) : "memory"); return r;
}
template <int D0> __device__ __forceinline__ void pv_one(f32x16& od, int vb, bf16x8 pa0, bf16x8 pa1, bf16x8 pa2, bf16x8 pa3) {
  const s16x4 l0 = tr_read<v_rd_off(D0, 0, 0)>(vb), h0 = tr_read<v_rd_off(D0, 0, 1)>(vb), l1 = tr_read<v_rd_off(D0, 1, 0)>(vb), h1 = tr_read<v_rd_off(D0, 1, 1)>(vb);
  const s16x4 l2 = tr_read<v_rd_off(D0, 2, 0)>(vb), h2 = tr_read<v_rd_off(D0, 2, 1)>(vb), l3 = tr_read<v_rd_off(D0, 3, 0)>(vb), h3 = tr_read<v_rd_off(D0, 3, 1)>(vb);
  asm volatile("s_waitcnt lgkmcnt(0)" ::: "memory"); SBAR();
#define PK(L, H) (bf16x8){L[0], L[1], L[2], L[3], H[0], H[1], H[2], H[3]}
  od = __builtin_amdgcn_mfma_f32_32x32x16_bf16(pa0, PK(l0, h0), od, 0, 0, 0);
  od = __builtin_amdgcn_mfma_f32_32x32x16_bf16(pa1, PK(l1, h1), od, 0, 0, 0);
  od = __builtin_amdgcn_mfma_f32_32x32x16_bf16(pa2, PK(l2, h2), od, 0, 0, 0);
  od = __builtin_amdgcn_mfma_f32_32x32x16_bf16(pa3, PK(l3, h3), od, 0, 0, 0);
#undef PK
}
__device__ __forceinline__ void pv_d0(f32x16* o, int vb, bf16x8 pa0, bf16x8 pa1, bf16x8 pa2, bf16x8 pa3) {
  pv_one<0>(o[0], vb, pa0, pa1, pa2, pa3); pv_one<1>(o[1], vb, pa0, pa1, pa2, pa3); pv_one<2>(o[2], vb, pa0, pa1, pa2, pa3); pv_one<3>(o[3], vb, pa0, pa1, pa2, pa3);
}

template <int LDQ, int LDK, class Epi>
__device__ __forceinline__ void attn_dense_body(const bf16_t* __restrict__ Qb, const bf16_t* __restrict__ Kh, const bf16_t* __restrict__ Vh,
                                                int seq, char* lds, const Epi& epi, const int wv) {
  constexpr int SDEPTH = 2;
  const int tid = wv * 64 + fresh_lane();
  const int wid = wv, lane = tid & 63, r32 = lane & 31, hi = lane >> 5;
  bf16_t* V_lds = (bf16_t*)lds; bf16_t* K_lds = (bf16_t*)(lds + 2 * SHM_V);
  float* ws = (float*)(lds + 2 * SHM_V + 2 * SHM_K) + wid * 64; float* li_l = ws; float* al_l = ws + 32;
  float m_reg = -1e30f, l_reg = 0; f32x16 o[4] = {}; bf16x8 qr[8];
  const bf16_t* Qw = Qb + (unsigned)((wid * QBLK + r32) * LDQ + hi * 8);
#pragma unroll
  for (int d0 = 0; d0 < 8; ++d0) qr[d0] = ld8(Qw + d0 * 16);
  const int sr = tid >> 4, sc = (tid & 15) * 8, vst0 = v_st(sr, sc), vst1 = v_st(32 + sr, sc);
  const int vb0 = (int)(uintptr_t)V_lds + v_rd_base(lane);
  struct { bf16x8 vs0, vs1, ks0, ks1; } sr_[SDEPTH];
  const unsigned soff = (unsigned)(sr * LDK + sc);
#define SLOAD(i, k0) do { const unsigned o0_ = soff + (unsigned)(k0) * LDK, o1_ = o0_ + 32u * LDK; sr_[i].vs0 = ld8(Vh + o0_); sr_[i].vs1 = ld8(Vh + o1_); \
    sr_[i].ks0 = ld8(Kh + o0_); sr_[i].ks1 = ld8(Kh + o1_); } while (0)
#define SWRITE(b, i) do { *(bf16x8*)((char*)V_lds + (b) * SHM_V + vst0) = sr_[i].vs0;          \
    *(bf16x8*)((char*)V_lds + (b) * SHM_V + vst1) = sr_[i].vs1; int kc = sc * 2;               \
    *(bf16x8*)((char*)K_lds + (b) * SHM_K + KSWZ(sr, kc)) = sr_[i].ks0;                       \
    *(bf16x8*)((char*)K_lds + (b) * SHM_K + KSWZ(32 + sr, kc)) = sr_[i].ks1; } while (0)
#define SWAIT() do { asm volatile("s_waitcnt vmcnt(4)" ::: "memory"); } while (0)
#define RESC(a) do { if (__any((a) < 1.f)) { if (hi == 0) al_l[r32] = (a); asm volatile("s_waitcnt lgkmcnt(0)" ::: "memory"); \
    for (int d = 0; d < 4; ++d) for (int r = 0; r < 16; ++r) o[d][r] *= al_l[crow(r, hi)]; } } while (0)
  f32x16 pA0, pA1, pB0, pB1; float mnA, mnB, alA, alB; bf16x8 pa0, pa1, pa2, pa3; const int NT = seq / KVBLK;
  constexpr int SE = 0, SO = SDEPTH - 1;
  SLOAD(SE, 0); asm volatile("s_waitcnt vmcnt(0)" ::: "memory"); SWRITE(0, SE); __syncthreads();
  qkt(pA0, pA1, K_lds, qr, r32, hi); partialSM(pA0, pA1, m_reg, mnA, alA);
  SLOAD(SO, KVBLK); if (2 < NT) SLOAD(SE, 2 * KVBLK);
  SWAIT(); SWRITE(1, SO); __syncthreads();
  for (int j = 1; j + 1 < NT; j += 2) {
    SBAR(); qkt(pB0, pB1, (bf16_t*)((char*)K_lds + SHM_K), qr, r32, hi);
    finishSM(pA0, pA1, alA, l_reg, pa0, pa1, pa2, pa3); SBAR();
    SLOAD(SO, (j + SDEPTH) * KVBLK); SBAR();
    pv_d0(o, vb0, pa0, pa1, pa2, pa3); partialSM(pB0, pB1, m_reg, mnB, alB);
    __syncthreads(); SWAIT(); SWRITE(0, SE);
    RESC(alB); __syncthreads();
    SBAR(); qkt(pA0, pA1, K_lds, qr, r32, hi);
    finishSM(pB0, pB1, alB, l_reg, pa0, pa1, pa2, pa3); SBAR();
    if (j + 3 < NT) SLOAD(SE, (j + 1 + SDEPTH) * KVBLK); SBAR();
    pv_d0(o, vb0 + (int)SHM_V, pa0, pa1, pa2, pa3); partialSM(pA0, pA1, m_reg, mnA, alA);
    __syncthreads(); SWAIT(); SWRITE(1, SO);
    RESC(alA); __syncthreads();
  }
  SBAR(); qkt(pB0, pB1, (bf16_t*)((char*)K_lds + SHM_K), qr, r32, hi);
  finishSM(pA0, pA1, alA, l_reg, pa0, pa1, pa2, pa3); SBAR();
  pv_d0(o, vb0, pa0, pa1, pa2, pa3); partialSM(pB0, pB1, m_reg, mnB, alB);
  __syncthreads(); RESC(alB);
  finishSM(pB0, pB1, alB, l_reg, pa0, pa1, pa2, pa3); SBAR();
  pv_d0(o, vb0 + (int)SHM_V, pa0, pa1, pa2, pa3);
  if (hi == 0) li_l[r32] = l_reg; asm volatile("s_waitcnt lgkmcnt(0)" ::: "memory");
  float rli[16];
#pragma unroll
  for (int r = 0; r < 16; ++r) rli[r] = __builtin_amdgcn_rcpf(li_l[crow(r, hi)]);
  epi(o, rli, wid, r32, hi, lane);
#undef SLOAD
#undef SWRITE
#undef SWAIT
#undef RESC
}

struct EpiA {
  const bf16_t* z0;
  unsigned char* ao0;
  __device__ __forceinline__ void operator()(f32x16 (&o)[4], const float (&rli)[16], int wid, int r32, int hi, int lane, char* lds) const {
    float* st = (float*)(lds + wid * 16384);
    unsigned wb = (unsigned)(4 * hi * 128 + r32); asm volatile("" : "+v"(wb));
#pragma unroll
    for (int r = 0; r < 16; ++r) { const unsigned cr = (r & 3) + 8 * (r >> 2);
#pragma unroll
      for (int d0 = 0; d0 < 4; ++d0) st[wb + cr * 128 + d0 * 32] = o[d0][r] * rli[r]; }
    unsigned rr = (unsigned)(lane >> 4), c8 = (unsigned)(lane & 15) * 8; asm volatile("" : "+v"(rr), "+v"(c8));
    const unsigned zb = (unsigned)(wid * QBLK + rr) * A_IN + c8, ob = (unsigned)(wid * QBLK + rr) * DM + c8, sb = rr * 128 + c8;
#pragma unroll
    for (int i = 0; i < 8; ++i) {
      const f32x4 a = *(const f32x4*)(st + sb + i * 512), b = *(const f32x4*)(st + sb + i * 512 + 4);
      const bf16x8 zz = *(const bf16x8*)(z0 + zb + (unsigned)(i * 4) * A_IN);
      float g[8];
#pragma unroll
      for (int k = 0; k < 8; ++k) g[k] = silu_f(bf2f((bf16_t)zz[k])) * F8_ASCALE;
      u32x2 w; w.x = pk4_fp8(a[0] * g[0], a[1] * g[1], a[2] * g[2], a[3] * g[3]); w.y = pk4_fp8(b[0] * g[4], b[1] * g[5], b[2] * g[6], b[3] * g[7]);
      *(u32x2*)(ao0 + ob + (unsigned)(i * 4) * DM) = w; }
    __syncthreads();
  }
};
struct EpiB {
  int c, vh; float lam, oscale;
  const bf16_t* z0;
  bf16_t* ao0;
  const float* sg;
  unsigned* stash;
  float* ssq;
  __device__ __forceinline__ void operator()(f32x16 (&o)[4], const float (&rli)[16], int wid, int r32, int hi, int lane) const {
    unsigned* st = stash + (wid * 32) * 64 + lane;
    if (c == 0) {
#pragma unroll
      for (int d0 = 0; d0 < 4; ++d0)
#pragma unroll
        for (int q = 0; q < 8; ++q) st[(d0 * 8 + q) * 64] = cvtpk(o[d0][2 * q] * rli[2 * q], o[d0][2 * q + 1] * rli[2 * q + 1]);
      return;
    }
    float ss[16];
#pragma unroll
    for (int r = 0; r < 16; ++r) ss[r] = 0.f;
#pragma unroll
    for (int d0 = 0; d0 < 4; ++d0)
#pragma unroll
      for (int q = 0; q < 8; ++q) { const unsigned u = st[(d0 * 8 + q) * 64];
        const float da = __uint_as_float(u << 16) - lam * (o[d0][2 * q] * rli[2 * q]);
        const float db = __uint_as_float(u & 0xffff0000u) - lam * (o[d0][2 * q + 1] * rli[2 * q + 1]);
        o[d0][2 * q] = da; o[d0][2 * q + 1] = db; ss[2 * q] += da * da; ss[2 * q + 1] += db * db; }
#pragma unroll
    for (int r = 0; r < 16; ++r) { ss[r] += swz_xor<1>(ss[r]); ss[r] += swz_xor<2>(ss[r]); ss[r] += swz_xor<4>(ss[r]); ss[r] += swz_xor<8>(ss[r]); ss[r] += swz_xor<16>(ss[r]); }
    float* sq = ssq + wid * 32 + 4 * hi;
    unsigned lb = (unsigned)(wid * QBLK + 4 * hi); asm volatile("" : "+v"(lb));
    const unsigned zo = lb * B_IN + r32, oo = lb * DM + r32;
    if (vh == 0) {
#pragma unroll
      for (int r = 0; r < 16; ++r) { const unsigned cr = (r & 3) + 8 * (r >> 2);
        if (r32 == 0) sq[cr] = ss[r];
#pragma unroll
        for (int d0 = 0; d0 < 4; ++d0) ao0[oo + cr * DM + d0 * 32] = f2bf(o[d0][r]); }
      return;
    }
    LDS_WAIT();
#pragma unroll
    for (int r = 0; r < 16; ++r) { const unsigned cr = (r & 3) + 8 * (r >> 2);
      const float rs = __builtin_amdgcn_rsqf((ss[r] + sq[cr]) * (1.f / 256.f) + EPS) * oscale;
#pragma unroll
      for (int d0 = 0; d0 < 4; ++d0) { const unsigned col = d0 * 32;
        const float z1 = bf2f(z0[zo + cr * B_IN + 128 + col]);
        ao0[oo + cr * DM + 128 + col] = f2bf(o[d0][r] * rs * sg[128 + col + r32] * silu_f(z1));
        const float dv = bf2f(ao0[oo + cr * DM + col]); const float z0v = bf2f(z0[zo + cr * B_IN + col]);
        ao0[oo + cr * DM + col] = f2bf(dv * rs * sg[col + r32] * silu_f(z0v)); } }
  }
};

template <bool AXIAL>
__device__ __forceinline__ void q_prep(bf16x8 (&qr)[8], const float* __restrict__ g, const int t, const int hi, const float* __restrict__ inv64, i32x8* qf = nullptr) {
  constexpr float QS = SCALE * 1.4426950408889634f, INV2PI = 0.15915494309189535f;
  float x[8][8]; float ss = 0.f;
#pragma unroll
  for (int d0 = 0; d0 < 8; ++d0)
#pragma unroll
    for (int k = 0; k < 8; ++k) { x[d0][k] = bf2f((bf16_t)qr[d0][k]); ss += x[d0][k] * x[d0][k]; }
  { auto rr = __builtin_amdgcn_permlane32_swap(__float_as_uint(ss), __float_as_uint(ss), false, false); ss = __uint_as_float(rr[0]) + __uint_as_float(rr[1]); }
  const float rs = __builtin_amdgcn_rsqf(ss * (1.f / 128.f) + EPS) * QS;
#pragma unroll
  for (int d0 = 0; d0 < 8; ++d0) { const f32x4 g0 = *(const f32x4*)(g + d0 * 16 + hi * 8), g1 = *(const f32x4*)(g + d0 * 16 + hi * 8 + 4);
#pragma unroll
    for (int k = 0; k < 4; ++k) { x[d0][k] *= rs * g0[k]; x[d0][4 + k] *= rs * g1[k]; } }
#pragma unroll
  for (int p = 0; p < 4; ++p) {
    const int da = AXIAL ? (p >> 1) * 4 + (p & 1) : p, db = AXIAL ? da + 2 : da + 4;
    const float pos = AXIAL ? (float)((p >> 1) ? (t & 63) : (t >> 6)) : (float)t;
#pragma unroll
    for (int k = 0; k < 8; ++k) {
      const int j = AXIAL ? 2 * ((p & 1) * 16 + hi * 8 + k) : p * 16 + hi * 8 + k;
      const float rev = __builtin_amdgcn_fractf(pos * (inv64[j] * INV2PI));
      const float c = __builtin_amdgcn_cosf(rev), s = __builtin_amdgcn_sinf(rev);
      const float a = x[da][k], b = x[db][k];
      x[da][k] = a * c - b * s; x[db][k] = b * c + a * s; } }
  if (qf) {
#pragma unroll
    for (int s = 0; s < 2; ++s)
#pragma unroll
      for (int c = 0; c < 4; ++c) { qf[s][2 * c] = (int)pk4_fp8(x[4 * s + c][0] * 8.f, x[4 * s + c][1] * 8.f, x[4 * s + c][2] * 8.f, x[4 * s + c][3] * 8.f);
        qf[s][2 * c + 1] = (int)pk4_fp8(x[4 * s + c][4] * 8.f, x[4 * s + c][5] * 8.f, x[4 * s + c][6] * 8.f, x[4 * s + c][7] * 8.f); }
    return; }
#pragma unroll
  for (int d0 = 0; d0 < 8; ++d0) { u32x4 w = {cvtpk2(x[d0][0], x[d0][1]), cvtpk2(x[d0][2], x[d0][3]), cvtpk2(x[d0][4], x[d0][5]), cvtpk2(x[d0][6], x[d0][7])}; qr[d0] = *reinterpret_cast<bf16x8*>(&w); }
}

constexpr size_t DV_OFF = 0, DK_OFF = 98304, DPX_OFF = 131072, DXL_OFF = DPX_OFF, DXS_OFF = DPX_OFF + 1024;
template <int D0> __device__ __forceinline__ void pv_split(f32x16& od, int vbo, int vbt, bf16x8 own0, bf16x8 own1, bf16x8 oth0, bf16x8 oth1) {
  const s16x4 l0 = tr_read<v_rd_off(D0, 0, 0)>(vbo), h0 = tr_read<v_rd_off(D0, 0, 1)>(vbo), l1 = tr_read<v_rd_off(D0, 1, 0)>(vbo), h1 = tr_read<v_rd_off(D0, 1, 1)>(vbo);
  const s16x4 l2 = tr_read<v_rd_off(D0, 0, 0)>(vbt), h2 = tr_read<v_rd_off(D0, 0, 1)>(vbt), l3 = tr_read<v_rd_off(D0, 1, 0)>(vbt), h3 = tr_read<v_rd_off(D0, 1, 1)>(vbt);
  asm volatile("s_waitcnt lgkmcnt(0)" ::: "memory"); SBAR();
#define PK(L, H) (bf16x8){L[0], L[1], L[2], L[3], H[0], H[1], H[2], H[3]}
  od = __builtin_amdgcn_mfma_f32_32x32x16_bf16(own0, PK(l0, h0), od, 0, 0, 0);
  od = __builtin_amdgcn_mfma_f32_32x32x16_bf16(own1, PK(l1, h1), od, 0, 0, 0);
  od = __builtin_amdgcn_mfma_f32_32x32x16_bf16(oth0, PK(l2, h2), od, 0, 0, 0);
  od = __builtin_amdgcn_mfma_f32_32x32x16_bf16(oth1, PK(l3, h3), od, 0, 0, 0);
#undef PK
}
struct EpiD {
  int c; float lam, oscale;
  const bf16_t* z0;
  bf16_t* ao0;
  const float* sg;
  unsigned* stash;
};
template <int LD>
__device__ __forceinline__ void attn_diff_body(const bf16_t* __restrict__ Qb, const bf16_t* __restrict__ Kh, const bf16_t* __restrict__ Vh,
                                               int seq, char* lds, const float nbC, const EpiD& epi, const int wv, const float* qg, const int t0, const float* inv64) {
  constexpr float C = SCALE * 1.4426950408889634f;
  const int lane = fresh_lane(), tid = wv * 64 + lane;
  const int rb = wv >> 1, kh = wv & 1, r32 = lane & 31, hi = lane >> 5;
  char* V_lds = lds + DV_OFF; char* K_lds = lds + DK_OFF; char* PX = lds + DPX_OFF;
  float* xl = (float*)(lds + DXL_OFF); float* xs = (float*)(lds + DXS_OFF);
  f32x16 o[4] = {}; bf16x8 qr[8]; float lsum = 0.f;
  const int vbase = (int)(uintptr_t)V_lds + kh * 16384 + v_rd_base(lane);
  const int vbo = vbase + kh * 8192, vbt = vbase + (1 - kh) * 8192;
  const int krow = (kh * 32 + r32);
  const int pxw = wv * 2048 + lane * 16, pxr = (wv ^ 1) * 2048 + lane * 16;
  const int krl = lane >> 4;
  const unsigned kof0 = (unsigned)((8 * wv + krl) * LD + (((lane & 15) ^ krl) * 8)) * 2u;
  const unsigned kof1 = (unsigned)((8 * wv + 4 + krl) * LD + (((lane & 15) ^ (4 + krl)) * 8)) * 2u;
  const int keyv = wv * 8 + ((lane & 31) >> 2);
  const unsigned vof = (unsigned)(keyv * LD + (lane >> 5) * 32 + (lane & 3) * 8) * 2u;
  LAS unsigned char* ldl = (LAS unsigned char*)lds;
#define DMA16(gp, lo) __builtin_amdgcn_global_load_lds((const unsigned*)(gp), (LAS unsigned*)(ldl + (lo)), 16, 0, 0)
#define DMA_TILE(t, kb, vo) do { const char* kg_ = (const char*)Kh + (size_t)(t) * (KVBLK * LD * 2); const char* vg_ = (const char*)Vh + (size_t)(t) * (KVBLK * LD * 2); \
    DMA16(kg_ + kof0, DK_OFF + (kb) * 16384 + wv * 2048); DMA16(kg_ + kof1, DK_OFF + (kb) * 16384 + wv * 2048 + 1024);                      \
    DMA16(vg_ + vof, DV_OFF + (vo) + wv * 2048); DMA16(vg_ + vof + 128, DV_OFF + (vo) + wv * 2048 + 1024);                                  \
    DMA16(vg_ + vof + 256, DV_OFF + (vo) + 16384 + wv * 2048); DMA16(vg_ + vof + 384, DV_OFF + (vo) + 16384 + wv * 2048 + 1024); } while (0)
#define WBAR(n) do { asm volatile("s_waitcnt vmcnt(" #n ") lgkmcnt(0)" ::: "memory"); __builtin_amdgcn_s_barrier(); asm volatile("" ::: "memory"); } while (0)
#define PK4(P, BASE, OUT) do { u32x4 w = {cvtpk2(P[BASE + 0], P[BASE + 1]), cvtpk2(P[BASE + 2], P[BASE + 3]), cvtpk2(P[BASE + 4], P[BASE + 5]), cvtpk2(P[BASE + 6], P[BASE + 7])}; \
    OUT = *reinterpret_cast<bf16x8*>(&w); } while (0)
#define EXPC(P, lo) do { _Pragma("unroll") for (int r = (lo); r < (lo) + 4; ++r) { P[r] = __builtin_amdgcn_exp2f(P[r]); lsum += P[r]; } } while (0)
#define PKW(p, o0, o1, b) do { PK4(p, 0, o0); PK4(p, 8, o1); *(bf16x8*)(PX + (b) * 16384 + pxw) = o0; *(bf16x8*)(PX + (b) * 16384 + pxw + 1024) = o1; } while (0)
#define KADDR() int sw_ = (r32 & 7) << 4; asm volatile("" : "+v"(sw_)); const int kr_ = kb0 + krow * 256;                                       \
    const int a0_ = kr_ + ((0 + hi * 16) ^ sw_), a1_ = kr_ + ((32 + hi * 16) ^ sw_), a2_ = kr_ + ((64 + hi * 16) ^ sw_), a3_ = kr_ + ((96 + hi * 16) ^ sw_)
#define KRD_LO(KB) do { kf[0] = lds_rd128<(KB) * 16384>(a0_); kf[1] = lds_rd128<(KB) * 16384>(a1_); kf[2] = lds_rd128<(KB) * 16384>(a2_); kf[3] = lds_rd128<(KB) * 16384>(a3_); } while (0)
#define KRD_HI(KB) do { kf[4] = lds_rd128<(KB) * 16384 + 128>(a0_); kf[5] = lds_rd128<(KB) * 16384 + 128>(a1_); kf[6] = lds_rd128<(KB) * 16384 + 128>(a2_); kf[7] = lds_rd128<(KB) * 16384 + 128>(a3_); } while (0)
#define QK1(p, d, n) do { asm volatile("s_waitcnt lgkmcnt(" #n ")" : "+v"(kf[d]) :: "memory"); p = __builtin_amdgcn_mfma_f32_32x32x16_bf16(kf[d], qr[d], (d) == 0 ? pinit : p, 0, 0, 0); } while (0)
#define TRB(T, D0, vo_, vt_) do { T[0] = tr_read<v_rd_off(D0, 0, 0)>(vo_); T[1] = tr_read<v_rd_off(D0, 0, 1)>(vo_); T[2] = tr_read<v_rd_off(D0, 1, 0)>(vo_); T[3] = tr_read<v_rd_off(D0, 1, 1)>(vo_); \
    T[4] = tr_read<v_rd_off(D0, 0, 0)>(vt_); T[5] = tr_read<v_rd_off(D0, 0, 1)>(vt_); T[6] = tr_read<v_rd_off(D0, 1, 0)>(vt_); T[7] = tr_read<v_rd_off(D0, 1, 1)>(vt_); } while (0)
#define TRW(T, n) asm volatile("s_waitcnt lgkmcnt(" #n ")" : "+v"(T[0]), "+v"(T[1]), "+v"(T[2]), "+v"(T[3]), "+v"(T[4]), "+v"(T[5]), "+v"(T[6]), "+v"(T[7]) :: "memory")
#define PKV(L, H) (bf16x8){L[0], L[1], L[2], L[3], H[0], H[1], H[2], H[3]}
#define MB(od, T, o0, o1, t0, t1) do { od = __builtin_amdgcn_mfma_f32_32x32x16_bf16(o0, PKV(T[0], T[1]), od, 0, 0, 0); od = __builtin_amdgcn_mfma_f32_32x32x16_bf16(o1, PKV(T[2], T[3]), od, 0, 0, 0); \
    od = __builtin_amdgcn_mfma_f32_32x32x16_bf16(t0, PKV(T[4], T[5]), od, 0, 0, 0); od = __builtin_amdgcn_mfma_f32_32x32x16_bf16(t1, PKV(T[6], T[7]), od, 0, 0, 0); } while (0)
#define STEP(KB, pn, o0, o1, n0, n1) do { const int vo_ = vbo + v0, vt_ = vbt + v0; KADDR();                                                    \
    ot0 = lds_rd128<(1 - (KB)) * 16384>(pxra); ot1 = lds_rd128<(1 - (KB)) * 16384 + 1024>(pxra); TRB(trA, 0, vo_, vt_); KRD_LO(KB);              \
    QK1(pn, 0, 3); QK1(pn, 1, 2); QK1(pn, 2, 1); QK1(pn, 3, 0);                                                                  \
    asm volatile("" : "+v"(ot0), "+v"(ot1) :: "memory"); TRW(trA, 0);                                      \
    KRD_HI(KB); TRB(trB, 1, vo_, vt_);                                                                                                          \
    QK1(pn, 4, 11); QK1(pn, 5, 10); QK1(pn, 6, 9); QK1(pn, 7, 8);                                                                               \
    MB(o[0], trA, o0, o1, ot0, ot1); EXPC(pn, 0); TRW(trB, 0); TRB(trA, 2, vo_, vt_);                                                           \
    MB(o[1], trB, o0, o1, ot0, ot1); EXPC(pn, 4); TRW(trA, 0); TRB(trB, 3, vo_, vt_);                                                           \
    MB(o[2], trA, o0, o1, ot0, ot1); EXPC(pn, 8); TRW(trB, 0);                                                                                 \
    MB(o[3], trB, o0, o1, ot0, ot1); EXPC(pn, 12);                                                                                             \
    PKW(pn, n0, n1, KB); } while (0)
  f32x16 pA, pB, pinit; bf16x8 ownA0, ownA1, ownB0, ownB1, ot0, ot1, kf[8]; s16x4 trA[8], trB[8]; const int NT = seq / KVBLK;
  { float nb_ = nbC; asm volatile("" : "+v"(nb_));
#pragma unroll
    for (int r = 0; r < 16; ++r) pinit[r] = nb_; }
  asm volatile("" : "+v"(pinit));
  const int kb0 = (int)(uintptr_t)K_lds, pxra = (int)(uintptr_t)PX + pxr;
  int v0 = 0, v1 = 32768, v2 = 65536;
  DMA_TILE(0, 0, 0); DMA_TILE(1, 1, 32768);
  { const bf16_t* Qw = Qb + (unsigned)((rb * QBLK + r32) * LD + hi * 8);
    _Pragma("unroll")
    for (int d0 = 0; d0 < 8; ++d0) qr[d0] = ld8(Qw + d0 * 16);
    q_prep<false>(qr, qg, t0 + rb * QBLK + r32, hi, inv64); }
  WBAR(0);
  { KADDR(); KRD_LO(0); KRD_HI(0); QK1(pA, 0, 7); QK1(pA, 1, 6); QK1(pA, 2, 5); QK1(pA, 3, 4); QK1(pA, 4, 3); QK1(pA, 5, 2); QK1(pA, 6, 1); QK1(pA, 7, 0); }
  EXPC(pA, 0); EXPC(pA, 4); EXPC(pA, 8); EXPC(pA, 12); PKW(pA, ownA0, ownA1, 0);
  WBAR(0);
  for (int j = 1; j + 1 < NT; j += 2) {
    DMA_TILE(j + 1, 0, v2);
    STEP(1, pB, ownA0, ownA1, ownB0, ownB1);
    WBAR(0);
    { const int t = v0; v0 = v1; v1 = v2; v2 = t; }
    DMA_TILE(j + 2, 1, v2);
    STEP(0, pA, ownB0, ownB1, ownA0, ownA1);
    WBAR(0);
    { const int t = v0; v0 = v1; v1 = v2; v2 = t; }
  }
  STEP(1, pB, ownA0, ownA1, ownB0, ownB1);
  WBAR(0);
  { const int vo_ = vbo + v1, vt_ = vbt + v1;
    ot0 = lds_rd128<16384>(pxra); ot1 = lds_rd128<16384 + 1024>(pxra);
    TRB(trA, 0, vo_, vt_);
    asm volatile("s_waitcnt lgkmcnt(0)" : "+v"(ot0), "+v"(ot1) :: "memory"); TRW(trA, 0); TRB(trB, 1, vo_, vt_);
    MB(o[0], trA, ownB0, ownB1, ot0, ot1); TRW(trB, 0); TRB(trA, 2, vo_, vt_);
    MB(o[1], trB, ownB0, ownB1, ot0, ot1); TRW(trA, 0); TRB(trB, 3, vo_, vt_);
    MB(o[2], trA, ownB0, ownB1, ot0, ot1); TRW(trB, 0);
    MB(o[3], trB, ownB0, ownB1, ot0, ot1); }
  WBAR(0);
#undef DMA16
#undef DMA_TILE
#undef WBAR
#undef PK4
#undef EXPC
#undef PKW
#undef KADDR
#undef KRD_LO
#undef KRD_HI
#undef QK1
#undef TRB
#undef TRW
#undef PKV
#undef MB
#undef STEP
  { auto rr = __builtin_amdgcn_permlane32_swap(__float_as_uint(lsum), __float_as_uint(lsum), false, false);
    lsum = __uint_as_float(rr[0]) + __uint_as_float(rr[1]); }
  if (hi == 0) xl[wv * 32 + r32] = lsum;
  __syncthreads();
  float rli[16];
#pragma unroll
  for (int r = 0; r < 16; ++r) { const int cr = crow(r, hi); rli[r] = __builtin_amdgcn_rcpf(xl[wv * 32 + cr] + xl[(wv ^ 1) * 32 + cr]); }
  unsigned* st = epi.stash + (wv * 32) * 64 + lane;
  if (epi.c == 0) {
#pragma unroll
    for (int d0 = 0; d0 < 4; ++d0)
#pragma unroll
      for (int q = 0; q < 8; ++q) st[(d0 * 8 + q) * 64] = cvtpk(o[d0][2 * q] * rli[2 * q], o[d0][2 * q + 1] * rli[2 * q + 1]);
    return;
  }
  float ss[16];
#pragma unroll
  for (int r = 0; r < 16; ++r) ss[r] = 0.f;
#pragma unroll
  for (int d0 = 0; d0 < 4; ++d0)
#pragma unroll
    for (int q = 0; q < 8; ++q) { const unsigned u = st[(d0 * 8 + q) * 64];
      const float da = __uint_as_float(u << 16) - epi.lam * (o[d0][2 * q] * rli[2 * q]);
      const float db = __uint_as_float(u & 0xffff0000u) - epi.lam * (o[d0][2 * q + 1] * rli[2 * q + 1]);
      o[d0][2 * q] = da; o[d0][2 * q + 1] = db; ss[2 * q] += da * da; ss[2 * q + 1] += db * db; }
#pragma unroll
  for (int r = 0; r < 16; ++r) { ss[r] += swz_xor<1>(ss[r]); ss[r] += swz_xor<2>(ss[r]); ss[r] += swz_xor<4>(ss[r]); ss[r] += swz_xor<8>(ss[r]); ss[r] += swz_xor<16>(ss[r]); }
  if (r32 == 0) {
#pragma unroll
    for (int r = 0; r < 16; ++r) xs[wv * 32 + crow(r, hi)] = ss[r]; }
  __syncthreads();
  float* stg = (float*)(lds + wv * 16384);
  unsigned wb = (unsigned)(4 * hi * 128 + r32); asm volatile("" : "+v"(wb));
#pragma unroll
  for (int r = 0; r < 16; ++r) { const unsigned cr = (r & 3) + 8 * (r >> 2);
    const float rs = __builtin_amdgcn_rsqf((ss[r] + xs[(wv ^ 1) * 32 + cr + 4 * hi]) * (1.f / 256.f) + EPS) * epi.oscale;
#pragma unroll
    for (int d0 = 0; d0 < 4; ++d0) stg[wb + cr * 128 + d0 * 32] = o[d0][r] * rs; }
  unsigned rr = (unsigned)(lane >> 4), c8 = (unsigned)(lane & 15) * 8; asm volatile("" : "+v"(rr), "+v"(c8));
  const unsigned zb = (unsigned)(rb * QBLK + rr) * LD + kh * 128 + c8, ob = (unsigned)(rb * QBLK + rr) * DM + kh * 128 + c8, sb = rr * 128 + c8;
  const f32x4 sg0 = *(const f32x4*)(epi.sg + kh * 128 + c8), sg1 = *(const f32x4*)(epi.sg + kh * 128 + c8 + 4);
#pragma unroll
  for (int i = 0; i < 8; ++i) {
    const f32x4 a = *(const f32x4*)(stg + sb + i * 512), b = *(const f32x4*)(stg + sb + i * 512 + 4);
    const bf16x8 zz = *(const bf16x8*)(epi.z0 + zb + (unsigned)(i * 4) * LD);
    float g[8];
#pragma unroll
    for (int k = 0; k < 8; ++k) g[k] = silu_f(bf2f((bf16_t)zz[k]));
    u32x4 w; w.x = cvtpk2(a[0] * sg0[0] * g[0], a[1] * sg0[1] * g[1]); w.y = cvtpk2(a[2] * sg0[2] * g[2], a[3] * sg0[3] * g[3]);
    w.z = cvtpk2(b[0] * sg1[0] * g[4], b[1] * sg1[1] * g[5]); w.w = cvtpk2(b[2] * sg1[2] * g[6], b[3] * sg1[3] * g[7]);
    *(u32x4*)(epi.ao0 + ob + (unsigned)(i * 4) * DM) = w; }
  __syncthreads();
}
constexpr size_t AV_OFF = 0, AK_OFF = 49152, AW_OFF = 131072;
template <int LD, class Epi>
__device__ __forceinline__ void attn_gqa_body(const bf16_t* __restrict__ Qb, const bf16_t* __restrict__ Kh, const bf16_t* __restrict__ Vh,
                                              int seq, char* lds, const float nbC, const Epi& epi, const int wv, const float* qg, const int t0, const float* inv64) {
  constexpr float C = SCALE * 1.4426950408889634f;
  const int lane = fresh_lane(), r32 = lane & 31, hi = lane >> 5;
  char* V_lds = lds + AV_OFF; char* K_lds = lds + AK_OFF;
  float* li_l = (float*)(lds + AW_OFF) + wv * 64;
  f32x16 o[4] = {}; bf16x8 qr[8]; float lsum = 0.f;
  const int vb0 = (int)(uintptr_t)V_lds + v_rd_base(lane);
  const int kb0 = (int)(uintptr_t)K_lds;
  const unsigned kof8 = (unsigned)((8 * wv + (lane >> 3)) * (LD * 2) + (((lane & 7) ^ ((lane >> 3) & 7)) * 16));
  const int keyv = wv * 8 + ((lane & 31) >> 2);
  const unsigned vof = (unsigned)(keyv * LD + (lane >> 5) * 32 + (lane & 3) * 8) * 2u;
  LAS unsigned char* ldl = (LAS unsigned char*)lds;
#define DMA16(gp, lo) __builtin_amdgcn_global_load_lds((const unsigned*)(gp), (LAS unsigned*)(ldl + (lo)), 16, 0, 0)
#define DMA_TILE(t, kb, vo) do { const char* kg_ = (const char*)Kh + (size_t)(t) * (KVBLK * LD * 2); const char* vg_ = (const char*)Vh + (size_t)(t) * (KVBLK * LD * 2); \
    DMA16(kg_ + kof8, AK_OFF + (kb) * 16384 + wv * 1024);                                                                                   \
    DMA16(vg_ + vof, AV_OFF + (vo) + wv * 2048); DMA16(vg_ + vof + 128, AV_OFF + (vo) + wv * 2048 + 1024); } while (0)
#define WBAR(n) do { asm volatile("s_waitcnt vmcnt(" #n ") lgkmcnt(0)" ::: "memory"); __builtin_amdgcn_s_barrier(); asm volatile("" ::: "memory"); } while (0)
#define PK4(P, BASE, OUT) do { u32x4 w = {cvtpk2(P[BASE + 0], P[BASE + 1]), cvtpk2(P[BASE + 2], P[BASE + 3]), cvtpk2(P[BASE + 4], P[BASE + 5]), cvtpk2(P[BASE + 6], P[BASE + 7])}; \
    OUT = *reinterpret_cast<bf16x8*>(&w); } while (0)
#define EXPC(P, lo) do { _Pragma("unroll") for (int r = (lo); r < (lo) + 8; ++r) { P[r] = __builtin_amdgcn_exp2f(P[r]); lsum += P[r]; } } while (0)
#define PACK() do { PK4(p0, 0, pa0); PK4(p0, 8, pa1); PK4(p1, 0, pa2); PK4(p1, 8, pa3); } while (0)
#ifndef NOINT_A
#define PVX(vo) do { pv_one<0>(o[0], vb0 + (vo), pa0, pa1, pa2, pa3); EXPC(p0, 0); pv_one<1>(o[1], vb0 + (vo), pa0, pa1, pa2, pa3); EXPC(p0, 8);    \
    pv_one<2>(o[2], vb0 + (vo), pa0, pa1, pa2, pa3); EXPC(p1, 0); pv_one<3>(o[3], vb0 + (vo), pa0, pa1, pa2, pa3); EXPC(p1, 8); SBAR(); PACK(); } while (0)
#else
#define PVX(vo) do { pv_d0(o, vb0 + (vo), pa0, pa1, pa2, pa3); EXPC(p0, 0); EXPC(p0, 8); EXPC(p1, 0); EXPC(p1, 8); SBAR(); PACK(); } while (0)
#endif
#define KADDR() int sw_ = (r32 & 7); asm volatile("" : "+v"(sw_)); const int kr_ = kb0 + r32 * 128;                                               \
    const int a0_ = kr_ + (((2 * hi) ^ sw_) << 4), a1_ = kr_ + (((2 * hi + 1) ^ sw_) << 4), a2_ = kr_ + (((4 + 2 * hi) ^ sw_) << 4), a3_ = kr_ + (((5 + 2 * hi) ^ sw_) << 4)
#define KLD(dst, A0, A1, OFF) do { dst.lo = *(const LAS i32x4*)(unsigned)((A0) + (OFF)); dst.hi = *(const LAS i32x4*)(unsigned)((A1) + (OFF)); } while (0)
#define MF8(dst, ka, qv, cin) asm volatile("v_mfma_scale_f32_32x32x64_f8f6f4 %0, %1, %2, %3, %4, %4 op_sel_hi:[0,0,0]" : "=&v"(dst) : "v"(ka), "v"(qv), "v"(cin), "v"(f8one))
#define MF8A(dst, ka, qv) asm volatile("v_mfma_scale_f32_32x32x64_f8f6f4 %0, %1, %2, %0, %3, %3 op_sel_hi:[0,0,0]" : "+v"(dst) : "v"(ka), "v"(qv), "v"(f8one))
#define TRA(T, D0, vb_) do { T[0] = tr_read<v_rd_off(D0, 0, 0)>(vb_); T[1] = tr_read<v_rd_off(D0, 0, 1)>(vb_); T[2] = tr_read<v_rd_off(D0, 1, 0)>(vb_); T[3] = tr_read<v_rd_off(D0, 1, 1)>(vb_); \
    T[4] = tr_read<v_rd_off(D0, 2, 0)>(vb_); T[5] = tr_read<v_rd_off(D0, 2, 1)>(vb_); T[6] = tr_read<v_rd_off(D0, 3, 0)>(vb_); T[7] = tr_read<v_rd_off(D0, 3, 1)>(vb_); } while (0)
#define TRW(T, n) asm volatile("s_waitcnt lgkmcnt(" #n ")" : "+v"(T[0]), "+v"(T[1]), "+v"(T[2]), "+v"(T[3]), "+v"(T[4]), "+v"(T[5]), "+v"(T[6]), "+v"(T[7]) :: "memory")
#define PKV(L, H) (bf16x8){L[0], L[1], L[2], L[3], H[0], H[1], H[2], H[3]}
#define MB(od, T) do { od = __builtin_amdgcn_mfma_f32_32x32x16_bf16(pa0, PKV(T[0], T[1]), od, 0, 0, 0); od = __builtin_amdgcn_mfma_f32_32x32x16_bf16(pa1, PKV(T[2], T[3]), od, 0, 0, 0); \
    od = __builtin_amdgcn_mfma_f32_32x32x16_bf16(pa2, PKV(T[4], T[5]), od, 0, 0, 0); od = __builtin_amdgcn_mfma_f32_32x32x16_bf16(pa3, PKV(T[6], T[7]), od, 0, 0, 0); } while (0)
#define PZ() f32x16 pz_; { float nb_ = nbC; asm volatile("" : "+v"(nb_)); _Pragma("unroll") for (int r = 0; r < 16; ++r) pz_[r] = nb_; }
#define SCORES(KOFF) do { PZ(); i32x8 k0_, k1_, k2_, k3_;                                                                                      \
    KLD(k0_, a0_, a1_, (KOFF)); KLD(k1_, a0_, a1_, (KOFF) + 4096); KLD(k2_, a2_, a3_, (KOFF)); KLD(k3_, a2_, a3_, (KOFF) + 4096);              \
    MF8(p0, k0_, qf[0], pz_); MF8(p1, k1_, qf[0], pz_); MF8A(p0, k2_, qf[1]); MF8A(p1, k3_, qf[1]);                                            \
    asm volatile("s_nop 15\n\ts_nop 15" ::: "memory"); } while (0)
#define STEP(KOFF) do { const int vb_ = vb0 + v0; KADDR(); PZ(); i32x8 k0_, k1_, k2_, k3_;                                                      \
    TRA(trA, 0, vb_);                                                                                                                          \
    KLD(k0_, a0_, a1_, (KOFF)); KLD(k1_, a0_, a1_, (KOFF) + 4096);                                                                              \
    MF8(p0, k0_, qf[0], pz_); MF8(p1, k1_, qf[0], pz_);                                                                                        \
    KLD(k2_, a2_, a3_, (KOFF)); KLD(k3_, a2_, a3_, (KOFF) + 4096);                                                                              \
    TRW(trA, 0); TRA(trB, 1, vb_);                                                                                                             \
    MF8A(p0, k2_, qf[1]); MF8A(p1, k3_, qf[1]);                                                                                                \
    MB(o[0], trA); TRW(trB, 0); TRA(trA, 2, vb_);                                                                                              \
    MB(o[1], trB); asm volatile("s_nop 7" ::: "memory"); EXPC(p0, 0); TRW(trA, 0); TRA(trB, 3, vb_);                                           \
    MB(o[2], trA); EXPC(p0, 8); TRW(trB, 0);                                                                                                   \
    MB(o[3], trB); EXPC(p1, 0); EXPC(p1, 8);                                                                                                   \
    PACK(); } while (0)
  f32x16 p0, p1; bf16x8 pa0, pa1, pa2, pa3; i32x8 qf[2]; s16x4 trA[8], trB[8]; const int NT = seq / KVBLK;
  int f8one = 0x7F7F7F7F; asm volatile("" : "+v"(f8one));
  int v0 = 0, v1 = 16384, v2 = 32768;
  DMA_TILE(0, 0, 0); DMA_TILE(1, 1, 16384);
  { const bf16_t* Qw = Qb + (unsigned)((wv * QBLK + r32) * LD + hi * 8);
    _Pragma("unroll")
    for (int d0 = 0; d0 < 8; ++d0) qr[d0] = ld8(Qw + d0 * 16);
    q_prep<true>(qr, qg, t0 + wv * QBLK + r32, hi, inv64, qf); }
  WBAR(0);
  { KADDR(); SCORES(0); } EXPC(p0, 0); EXPC(p0, 8); EXPC(p1, 0); EXPC(p1, 8); PACK();
  WBAR(0);
  for (int j = 1; j + 1 < NT; j += 2) {
    DMA_TILE(j + 1, 0, v2);
    STEP(16384);
    WBAR(0);
    { const int t = v0; v0 = v1; v1 = v2; v2 = t; }
    DMA_TILE(j + 2, 1, v2);
    STEP(0);
    WBAR(0);
    { const int t = v0; v0 = v1; v1 = v2; v2 = t; }
  }
  STEP(16384);
  { const int vb_ = vb0 + v1;
    TRA(trA, 0, vb_); TRW(trA, 0); TRA(trB, 1, vb_);
    MB(o[0], trA); TRW(trB, 0); TRA(trA, 2, vb_);
    MB(o[1], trB); TRW(trA, 0); TRA(trB, 3, vb_);
    MB(o[2], trA); TRW(trB, 0);
    MB(o[3], trB); }
  WBAR(0);
#undef DMA16
#undef DMA_TILE
#undef WBAR
#undef PK4
#undef EXPC
#undef PACK
#undef PVX
#undef KADDR
#undef KLD
#undef MF8
#undef MF8A
#undef TRA
#undef TRW
#undef PKV
#undef MB
#undef SCORES
#undef STEP
#undef PZ
  { auto rr = __builtin_amdgcn_permlane32_swap(__float_as_uint(lsum), __float_as_uint(lsum), false, false);
    lsum = __uint_as_float(rr[0]) + __uint_as_float(rr[1]); }
  const int lane2 = fresh_lane(), r32e = lane2 & 31, hie = lane2 >> 5;
  if (hie == 0) li_l[r32e] = lsum; asm volatile("s_waitcnt lgkmcnt(0)" ::: "memory");
  float rli[16];
#pragma unroll
  for (int r = 0; r < 16; ++r) rli[r] = __builtin_amdgcn_rcpf(li_l[crow(r, hie)]);
  epi(o, rli, wv, r32e, hie, lane2, lds);
}
}

__device__ const float inv64_tab[64] = {
 1.000000000e+00f, 8.659643234e-01f, 7.498942093e-01f, 6.493816316e-01f, 5.623413252e-01f, 4.869675252e-01f, 4.216965034e-01f, 3.651741273e-01f, 3.162277660e-01f, 2.738419634e-01f, 2.371373706e-01f, 2.053525026e-01f, 1.778279410e-01f, 1.539926526e-01f, 1.333521432e-01f, 1.154781985e-01f,
 1.000000000e-01f, 8.659643234e-02f, 7.498942093e-02f, 6.493816316e-02f, 5.623413252e-02f, 4.869675252e-02f, 4.216965034e-02f, 3.651741273e-02f, 3.162277660e-02f, 2.738419634e-02f, 2.371373706e-02f, 2.053525026e-02f, 1.778279410e-02f, 1.539926526e-02f, 1.333521432e-02f, 1.154781985e-02f,
 1.000000000e-02f, 8.659643234e-03f, 7.498942093e-03f, 6.493816316e-03f, 5.623413252e-03f, 4.869675252e-03f, 4.216965034e-03f, 3.651741273e-03f, 3.162277660e-03f, 2.738419634e-03f, 2.371373706e-03f, 2.053525026e-03f, 1.778279410e-03f, 1.539926526e-03f, 1.333521432e-03f, 1.154781985e-03f,
 1.000000000e-03f, 8.659643234e-04f, 7.498942093e-04f, 6.493816316e-04f, 5.623413252e-04f, 4.869675252e-04f, 4.216965034e-04f, 3.651741273e-04f, 3.162277660e-04f, 2.738419634e-04f, 2.371373706e-04f, 2.053525026e-04f, 1.778279410e-04f, 1.539926526e-04f, 1.333521432e-04f, 1.154781985e-04f};

struct Args { const float* in[17]; float* out; unsigned char* ws; int ph_lo, ph_hi; };

__device__ __forceinline__ unsigned f2bf_sw(float f) { unsigned u = __float_as_uint(f); return (u + 0x7fffu + ((u >> 16) & 1u)) >> 16; }
__device__ __forceinline__ unsigned pk2(float lo, float hi) { return f2bf_sw(lo) | (f2bf_sw(hi) << 16); }

__device__ __forceinline__ void transpose_item(const float* W, int K, int N, bf16_t* WT, LAS float* scr, int item, int lane) {
  const int nblk = N / 32, kb = item / nblk, nb = item % nblk, k0 = 64 * kb, n0 = 32 * nb;
  { f32x4 t[8];
#pragma unroll
    for (int i = 0; i < 8; ++i) t[i] = *(const f32x4*)(W + (size_t)(k0 + 8 * i + (lane >> 3)) * N + n0 + (lane & 7) * 4);
#pragma unroll
    for (int i = 0; i < 8; ++i) { LAS float* d = scr + (8 * i + (lane >> 3)) * 33 + (lane & 7) * 4; d[0] = t[i].x; d[1] = t[i].y; d[2] = t[i].z; d[3] = t[i].w; } }
  LDS_WAIT(); asm volatile("" ::: "memory");
  const int c = lane & 7;
#pragma unroll
  for (int j = 0; j < 4; ++j) { const int n = (lane >> 3) + 8 * j; const LAS float* s = scr + (8 * c) * 33 + n;
    u32x4 o; o.x = pk2(s[0 * 33], s[1 * 33]); o.y = pk2(s[2 * 33], s[3 * 33]); o.z = pk2(s[4 * 33], s[5 * 33]); o.w = pk2(s[6 * 33], s[7 * 33]);
    *(u32x4*)(WT + (size_t)(n0 + n) * K + k0 + 8 * c) = o; }
  LDS_WAIT(); asm volatile("" ::: "memory");
}

__device__ __forceinline__ void transpose_item_f8(const float* W, int K, int N, unsigned char* WT, LAS float* scr, int item, int lane, float scale) {
  const int nblk = N / 32, kb = item / nblk, nb = item % nblk, k0 = 64 * kb, n0 = 32 * nb;
  { f32x4 t[8];
#pragma unroll
    for (int i = 0; i < 8; ++i) t[i] = *(const f32x4*)(W + (size_t)(k0 + 8 * i + (lane >> 3)) * N + n0 + (lane & 7) * 4);
#pragma unroll
    for (int i = 0; i < 8; ++i) { LAS float* d = scr + (8 * i + (lane >> 3)) * 33 + (lane & 7) * 4; d[0] = t[i].x * scale; d[1] = t[i].y * scale; d[2] = t[i].z * scale; d[3] = t[i].w * scale; } }
  LDS_WAIT(); asm volatile("" ::: "memory");
  const int c = lane & 3;
#pragma unroll
  for (int j = 0; j < 2; ++j) { const int n = (lane >> 2) + 16 * j; const LAS float* s = scr + (16 * c) * 33 + n;
    u32x4 o; o.x = pk4_fp8(s[0 * 33], s[1 * 33], s[2 * 33], s[3 * 33]); o.y = pk4_fp8(s[4 * 33], s[5 * 33], s[6 * 33], s[7 * 33]);
    o.z = pk4_fp8(s[8 * 33], s[9 * 33], s[10 * 33], s[11 * 33]); o.w = pk4_fp8(s[12 * 33], s[13 * 33], s[14 * 33], s[15 * 33]);
    *(u32x4*)(WT + (size_t)(n0 + n) * K + k0 + 16 * c) = o; }
  LDS_WAIT(); asm volatile("" ::: "memory");
}

__device__ __forceinline__ void phase_norm(const Args& a, int L, LAS unsigned char* lds, int wave, int lane, int bid) {
  const int isB = L & 1, jj = L >> 1, NIN = isB ? B_IN : A_IN;
  const float* Win = a.in[isB ? 8 : 3] + (size_t)jj * DM * NIN;
  const float* Wout = a.in[isB ? 16 : 6] + (size_t)jj * DM * DM;
  const float* ng = a.in[isB ? 7 : 2] + jj * DM;
  bf16_t* WinT = (bf16_t*)(a.ws + WS_WIN); bf16_t* WoutT = (bf16_t*)(a.ws + WS_WOUT); bf16_t* XN = (bf16_t*)(a.ws + WS_XN);
  LAS float* scr = (LAS float*)(lds + wave * 16384);
  const int gw = bid * 8 + wave, NGW = gridDim.x * 8;
  const int I_in = (DM / 64) * (NIN / 32), I_out = (DM / 64) * (DM / 32);
  for (int it = gw; it < I_in + I_out; it += NGW) {
    if (isB) { if (it < I_in) transpose_item(Win, DM, NIN, WinT, scr, it, lane); else transpose_item(Wout, DM, DM, WoutT, scr, it - I_in, lane); }
    else { if (it < I_in) transpose_item_f8(Win, DM, NIN, (unsigned char*)WinT, scr, it, lane, F8_WSCALE); else transpose_item_f8(Wout, DM, DM, (unsigned char*)WoutT, scr, it - I_in, lane, F8_WSCALE); }
  }
  f32x4 g4[8];
#pragma unroll
  for (int j = 0; j < 8; ++j) g4[j] = ((const f32x4*)ng)[lane + 64 * j];
  for (int m = gw; m < M; m += NGW) {
    const float* xr = (L == 0) ? (m < MP ? a.in[0] + (size_t)m * DM : a.in[1] + (size_t)(m - MP) * DM) : a.out + (size_t)m * DM;
    f32x4 v[8]; float s = 0.f;
#pragma unroll
    for (int j = 0; j < 8; ++j) { v[j] = ((const f32x4*)xr)[lane + 64 * j]; s += (v[j].x * v[j].x + v[j].y * v[j].y) + (v[j].z * v[j].z + v[j].w * v[j].w); }
    const float rs = __builtin_amdgcn_rsqf(wave_sum(s) * (1.f / DM) + EPS);
    if (isB) { u32x2* o8 = (u32x2*)(XN + (size_t)m * DM) + lane;
#pragma unroll
      for (int j = 0; j < 8; ++j) { const f32x4 y = v[j] * rs * g4[j]; u32x2 w; w.x = cvtpk(y.x, y.y); w.y = cvtpk(y.z, y.w); o8[64 * j] = w; } }
    else { unsigned* o4 = (unsigned*)((unsigned char*)XN + (size_t)m * DM) + lane;
#pragma unroll
      for (int j = 0; j < 8; ++j) { const f32x4 y = v[j] * rs * g4[j]; o4[64 * j] = pk4_fp8(y.x, y.y, y.z, y.w); } }
  }
}

__device__ __forceinline__ void phase_qkrope(const Args& a, int L, LAS unsigned char* lds, int wave, int lane, int bid) {
  const int isB = L & 1, jj = L >> 1, NIN = isB ? B_IN : A_IN;
  const int nheads = isB ? 32 : 20;
  const float* qg = a.in[isB ? 9 : 4] + jj * 128; const float* kg = a.in[isB ? 10 : 5] + jj * 128;
  bf16_t* proj = (bf16_t*)(a.ws + WS_PROJ);
  LAS float* tbl = (LAS float*)(lds) + wave * 128;
  const int sub = lane & 15, grp = lane >> 4;
  float gq[8], gk[8];
#pragma unroll
  for (int k = 0; k < 8; ++k) { gq[k] = qg[sub * 8 + k] * (att::SCALE * 1.4426950408889634f); gk[k] = kg[sub * 8 + k]; }
  const int tb = isB ? (sub & 7) * 8 : ((sub >> 3) * 32 + (sub & 3) * 8);
  const int pmask = isB ? 8 : 4;
  const bool second = (sub & pmask) != 0;
  const float invf = isB ? inv64_tab[lane] : inv64_tab[2 * (lane & 31)];
  const int gw = bid * 8 + wave, NGW = gridDim.x * 8;
  for (int m = gw; m < M; m += NGW) {
    const int t = m < MP ? (m & (SEQ_P - 1)) : ((m - MP) & (SEQ_S - 1));
    const float pos = isB ? (float)t : (lane < 32 ? (float)(t >> 6) : (float)(t & 63));
    const float ang = pos * invf;
    tbl[lane] = cosf(ang); tbl[64 + lane] = sinf(ang);
    LDS_WAIT();
    float cs[8], sn[8];
#pragma unroll
    for (int k = 0; k < 8; ++k) { cs[k] = tbl[tb + k]; sn[k] = tbl[64 + tb + k]; }
    bf16_t* prow = proj + (size_t)m * NIN;
    bf16x8 raw[8];
#pragma unroll
    for (int q = 4; q < 8; ++q) if (q * 4 < nheads) raw[q] = *(const bf16x8*)(prow + (q * 4 + grp) * 128 + sub * 8);
#pragma unroll
    for (int q = 4; q < 8; ++q) if (q * 4 < nheads) {
      const int head = q * 4 + grp;
      float x[8]; float ss = 0.f;
#pragma unroll
      for (int k = 0; k < 8; ++k) { x[k] = bf2f((bf16_t)raw[q][k]); ss += x[k] * x[k]; }
      ss += swz_xor<1>(ss); ss += swz_xor<2>(ss); ss += swz_xor<4>(ss); ss += swz_xor<8>(ss);
      const float rs = __builtin_amdgcn_rsqf(ss * (1.f / 128.f) + EPS);
      const bool isq = head < 16;
      float y[8], p[8];
#pragma unroll
      for (int k = 0; k < 8; ++k) y[k] = x[k] * rs * (isq ? gq[k] : gk[k]);
#pragma unroll
      for (int k = 0; k < 8; ++k) p[k] = isB ? swz_xor<8>(y[k]) : swz_xor<4>(y[k]);
#pragma unroll
      for (int k = 0; k < 8; ++k) y[k] = second ? (y[k] * cs[k] + p[k] * sn[k]) : (y[k] * cs[k] - p[k] * sn[k]);
      if (isB) { u32x4 w; w.x = cvtpk(y[0], y[1]); w.y = cvtpk(y[2], y[3]); w.z = cvtpk(y[4], y[5]); w.w = cvtpk(y[6], y[7]);
        *(u32x4*)(prow + head * 128 + sub * 8) = w; }
      else {
        u32x2 w; w.x = pk4_fp8(y[0] * 0.125f, y[1] * 0.125f, y[2] * 0.125f, y[3] * 0.125f); w.y = pk4_fp8(y[4] * 0.125f, y[5] * 0.125f, y[6] * 0.125f, y[7] * 0.125f);
        *(u32x2*)((unsigned char*)(prow + head * 128) + 64 * (sub >> 3) + 32 * (sub & 1) + 8 * ((sub >> 1) & 3)) = w; }
    }
    LDS_WAIT();
  }
}

__device__ __forceinline__ float wave_max(float v) {
  v = fmaxf(v, swz_xor<1>(v)); v = fmaxf(v, swz_xor<2>(v)); v = fmaxf(v, swz_xor<4>(v)); v = fmaxf(v, swz_xor<8>(v)); v = fmaxf(v, swz_xor<16>(v));
  auto rr = __builtin_amdgcn_permlane32_swap(__float_as_uint(v), __float_as_uint(v), false, false);
  return fmaxf(__uint_as_float(rr[0]), __uint_as_float(rr[1]));
}
__device__ __forceinline__ void phase_attn_a(const Args& a, int L, char* lds, int wv, int bid) {
  const bf16_t* proj = (const bf16_t*)(a.ws + WS_PROJ); unsigned char* ao = (unsigned char*)(a.ws + WS_XN);
  float nbC;
  { const int lane = fresh_lane(); const float* qg = a.in[4] + (L >> 1) * 128; const float* kg = a.in[5] + (L >> 1) * 128;
    const float gq = wave_max(fmaxf(fabsf(qg[lane]), fabsf(qg[lane + 64]))), gk = wave_max(fmaxf(fabsf(kg[lane]), fabsf(kg[lane + 64])));
    nbC = -(128.f * gq * gk * 1.02f) * (att::SCALE * 1.4426950408889634f); }
  for (int vw = bid; vw < 256; vw += gridDim.x) {
    const int xcd = vw & 7, w = vw >> 3;
    for (int i = 0; i < 12; ++i) {
      int b, kvh, hl, qb, seq; long seq0;
      if (i < 4) { const int idx = i * 32 + w; b = xcd >> 2; kvh = xcd & 3; hl = idx >> 5; qb = idx & 31; seq = SEQ_S; seq0 = MP + (long)b * SEQ_S; }
      else { const int i2 = i - 4, pair = xcd * 4 + (i2 >> 1), idx = (i2 & 1) * 32 + w; b = pair >> 2; kvh = pair & 3; hl = idx >> 4; qb = idx & 15; seq = SEQ_P; seq0 = (long)b * SEQ_P; }
      const int h = kvh * 4 + hl; const long row0 = seq0 + qb * 256;
      att::EpiA E{proj + row0 * A_IN + 3072 + h * 128, ao + row0 * DM + h * 128};
      att::attn_gqa_body<A_IN, att::EpiA>(proj + row0 * A_IN + h * 128, proj + seq0 * A_IN + 2048 + kvh * 128, proj + seq0 * A_IN + 2560 + kvh * 128, seq, lds, nbC, E, wv, a.in[4] + (L >> 1) * 128, qb * 256, inv64_tab);
    }
  }
}
__device__ __forceinline__ void phase_attn_b(const Args& a, int L, char* lds, int wv, int bid) {
  const int lane = fresh_lane();
  const int jj = L >> 1;
  const bf16_t* proj = (const bf16_t*)(a.ws + WS_PROJ); bf16_t* ao = (bf16_t*)(a.ws + WS_XN);
  const float lam_init = 0.8f - 0.6f * expf(-0.3f * (float)L);
  float d1 = 0.f, d2 = 0.f, gq = 0.f, gk = 0.f;
  { const float* q1 = a.in[11] + jj * 128; const float* k1 = a.in[12] + jj * 128; const float* q2 = a.in[13] + jj * 128; const float* k2 = a.in[14] + jj * 128;
    const float* qg = a.in[9] + jj * 128; const float* kg = a.in[10] + jj * 128;
    d1 = q1[lane] * k1[lane] + q1[lane + 64] * k1[lane + 64]; d2 = q2[lane] * k2[lane] + q2[lane + 64] * k2[lane + 64];
    d1 = wave_sum(d1); d2 = wave_sum(d2);
    gq = wave_max(fmaxf(fabsf(qg[lane]), fabsf(qg[lane + 64]))); gk = wave_max(fmaxf(fabsf(kg[lane]), fabsf(kg[lane + 64]))); }
  const float lam = expf(d1) - expf(d2) + lam_init;
  const float nbC = -(128.f * gq * gk * 1.02f) * (att::SCALE * 1.4426950408889634f);
  const float* sg = a.in[15] + jj * 256;
  unsigned* stash = (unsigned*)(a.ws + WS_STASH + (size_t)bid * 65536);
  for (int vw = bid; vw < 256; vw += gridDim.x) {
    const int xcd = vw & 7, w = vw >> 3;
    for (int i = 0; i < 12; ++i) {
      int b, h, qb, seq; long seq0;
      if (i < 4) { const int pair = xcd * 2 + (i >> 1); b = pair >> 3; h = pair & 7; qb = (i & 1) * 32 + w; seq = SEQ_S; seq0 = MP + (long)b * SEQ_S; }
      else { const int pair = xcd * 8 + (i - 4); b = pair >> 3; h = pair & 7; qb = w; seq = SEQ_P; seq0 = (long)b * SEQ_P; }
      const long row0 = seq0 + qb * 128;
      for (int c = 0; c < 2; ++c) {
        att::EpiD E{c, lam, 1.f - lam_init, proj + row0 * B_IN + 6144 + h * 256, ao + row0 * DM + h * 256, sg, stash};
        att::attn_diff_body<B_IN>(proj + row0 * B_IN + (2 * h + c) * 128, proj + seq0 * B_IN + 2048 + (2 * h + c) * 128,
                                  proj + seq0 * B_IN + 4096 + h * 256, seq, lds, nbC, E, wv, a.in[9] + jj * 128, qb * 128, inv64_tab);
      }
    }
  }
}


__device__ __forceinline__ void grid_bar(unsigned* cnt, unsigned target) {
  asm volatile("s_waitcnt vmcnt(0) lgkmcnt(0)" ::: "memory");
  __syncthreads();
  if (threadIdx.x == 0) {
    __builtin_amdgcn_fence(__ATOMIC_RELEASE, "agent");
    asm volatile("s_waitcnt vmcnt(0)" ::: "memory");
    __hip_atomic_fetch_add(cnt, 1u, __ATOMIC_RELAXED, __HIP_MEMORY_SCOPE_AGENT);
    unsigned spins = 0;
    while (__hip_atomic_load(cnt, __ATOMIC_RELAXED, __HIP_MEMORY_SCOPE_AGENT) < target) { __builtin_amdgcn_s_sleep(2); if (++spins > (1u << 24)) break; }
    __builtin_amdgcn_fence(__ATOMIC_ACQUIRE, "agent");
    asm volatile("s_waitcnt vmcnt(0)" ::: "memory");
  }
  __syncthreads();
}

__global__ void __launch_bounds__(512) fwd_megakernel(Args a) {
  extern __shared__ __attribute__((aligned(16))) unsigned char lds[];
  cg::grid_group grid = cg::this_grid();
  LAS unsigned char* ldsl = (LAS unsigned char*)lds;
  const int wave0 = __builtin_amdgcn_readfirstlane(threadIdx.x >> 6);
  int dup_done = 0; (void)dup_done;
  for (int ph = a.ph_lo; ph < a.ph_hi; ++ph) {
    int bid = blockIdx.x; asm volatile("" : "+s"(bid));
    int wave = wave0; asm volatile("" : "+s"(wave));
    const int L = ph / 5, s = ph - 5 * L, isB = L & 1, NIN = isB ? B_IN : A_IN;
#ifndef PHM
#define PHM 63
#endif
    if (s == 0) { if (PHM & 1) phase_norm(a, L, ldsl, wave, fresh_lane(), bid); }
    else if (s == 1) { if (PHM & 2) {
      pg8::Gemm g{(const bf16_t*)(a.ws + WS_XN), (const bf16_t*)(a.ws + WS_WIN), M, NIN, DM}; pg8::StaticOrder S; S.init(M, NIN, (int)gridDim.x, bid);
      if (isB) { pg8::EpiBf16 E{(bf16_t*)(a.ws + WS_PROJ), NIN, 1.f};
        pg8::gemm_phase<pg8::EpiBf16, pg8::StaticOrder, true, true, false>(ldsl, g, S, E, wave * 64 + fresh_lane()); }
      else { g.K = DM / 2; pg8::EpiBf16 E{(bf16_t*)(a.ws + WS_PROJ), NIN, 1.f / F8_WSCALE};
        pg8::gemm_phase<pg8::EpiBf16, pg8::StaticOrder, true, true, true>(ldsl, g, S, E, wave * 64 + fresh_lane()); }
    } }
    else if (s == 2) { if (PHM & 4) phase_qkrope(a, L, ldsl, wave, fresh_lane(), bid); }
    else if (s == 3) { if (isB) { if (PHM & 8) phase_attn_b(a, L, (char*)lds, wave, bid); } else { if (PHM & 32) phase_attn_a(a, L, (char*)lds, wave, bid); } }
    else if (PHM & 16) {
      pg8::Gemm g{(const bf16_t*)(a.ws + WS_XN), (const bf16_t*)(a.ws + WS_WOUT), M, DM, DM}; pg8::StaticOrder S; S.init(M, DM, (int)gridDim.x, bid);
      pg8::EpiResid E{L == 0 ? a.in[0] : a.out, L == 0 ? a.in[1] : a.out + (size_t)MP * DM, a.out, isB ? 1.f : 1.f / (F8_WSCALE * F8_ASCALE)};
      if (isB) pg8::gemm_phase<pg8::EpiResid, pg8::StaticOrder, true, true, false>(ldsl, g, S, E, wave * 64 + fresh_lane());
      else { g.K = DM / 2; pg8::gemm_phase<pg8::EpiResid, pg8::StaticOrder, true, true, true>(ldsl, g, S, E, wave * 64 + fresh_lane()); }
    }
#ifdef DUP_MASK
    if (!dup_done && (((DUP_MASK) & 1 && s == 0) || ((DUP_MASK) & 2 && s == 1) || ((DUP_MASK) & 8 && s == 3 && isB) || ((DUP_MASK) & 32 && s == 3 && !isB) || ((DUP_MASK) & 64 && s == 4 && L == 0))) { dup_done = 1; --ph; grid.sync(); continue; }
    dup_done = 0;
#endif
    if (ph + 1 < a.ph_hi) {
      if (ph == a.ph_lo) { if (blockIdx.x == 0 && threadIdx.x == 0) __hip_atomic_store((unsigned*)(a.ws + WS_CTL), 0u, __ATOMIC_RELAXED, __HIP_MEMORY_SCOPE_AGENT);
        grid.sync(); }
#ifdef USE_CG_SYNC
      else grid.sync();
#else
      else grid_bar((unsigned*)(a.ws + WS_CTL), (unsigned)(ph - a.ph_lo) * gridDim.x);
#endif
    }
  }
}

extern "C" void kernel_launch(void* const* d_in, const int* in_sizes, int n_in, void* d_out, int out_size, void* d_ws, size_t ws_size, hipStream_t stream) {
  static int grid = 0;
  if (grid == 0) {
    if (n_in != 17 || out_size != M * DM || ws_size < WS_END) { fprintf(stderr, "kernel_launch: unexpected shapes (n_in %d out %d ws %zu)\n", n_in, out_size, ws_size); grid = -1; return; }
    if (hipFuncSetAttribute((const void*)fwd_megakernel, hipFuncAttributeMaxDynamicSharedMemorySize, LDS_BYTES) != hipSuccess) { fprintf(stderr, "kernel_launch: hipFuncSetAttribute failed\n"); grid = -1; return; }
    int dev = 0, cus = 0, per_cu = 0;
    hipGetDevice(&dev); hipDeviceGetAttribute(&cus, hipDeviceAttributeMultiprocessorCount, dev);
    if (hipOccupancyMaxActiveBlocksPerMultiprocessor(&per_cu, (const void*)fwd_megakernel, 512, LDS_BYTES) != hipSuccess || per_cu < 1) { fprintf(stderr, "kernel_launch: occupancy query failed (%d)\n", per_cu); per_cu = 1; }
    (void)hipGetLastError();
    grid = cus * 1;
    if (grid > cus * per_cu) grid = cus * per_cu;
  }
  if (grid < 0) return;
  Args a{};
  for (int i = 0; i < 17; ++i) a.in[i] = (const float*)d_in[i];
  a.out = (float*)d_out; a.ws = (unsigned char*)d_ws;
#if MK_N_LAUNCHES == 1
  a.ph_lo = 0; a.ph_hi = NPHASE;
  void* args[] = {&a};
  hipError_t e = hipLaunchCooperativeKernel((const void*)fwd_megakernel, dim3(grid), dim3(512), args, LDS_BYTES, stream);
  if (e != hipSuccess) fprintf(stderr, "kernel_launch: cooperative launch failed: %s (grid %d)\n", hipGetErrorString(e), grid);
#else
  for (int ph = 0; ph < NPHASE; ++ph) {
    a.ph_lo = ph; a.ph_hi = ph + 1;
    hipLaunchKernelGGL(fwd_megakernel, dim3(grid), dim3(512), LDS_BYTES, stream, a);
  }
#endif
}
```
